# Optimizing an MI355X kernel written in HIP

```python
import jax, jax.numpy as jnp
from jax import lax
import numpy as np

D_MODEL = 1024
BATCH = 8
SEQ = 2048
DEPTH = 1
DEC_BATCH = 128
DEC_SEQ = 1
PAST_LEN = 16384
PAGE_SIZE = 128

N_META = 16
RET_HEADS = 4
RET_HEAD_DIM = 128
RET_W = RET_HEADS * RET_HEAD_DIM
CONV_CH = D_MODEL - RET_W
CONV_WIDTH = 31
CHUNK = 128
ROPE_BASE = 10000.0
D_FF = ((8 * D_MODEL // 3 + 255) // 256) * 256
IN_COLS = 4 * RET_W + 2 * CONV_CH
EPS = 1e-6

kernel_name = "hymba_retnet_conformer_decode_step"


def rms_norm(x, w):
    x32 = x.astype(jnp.float32)
    y = x32 * lax.rsqrt(jnp.mean(x32 * x32, axis=-1, keepdims=True) + EPS)
    return (y * w.astype(jnp.float32)).astype(x.dtype)


def log_gammas():
    return jnp.log(1.0 - 2.0 ** (-5.0 - jnp.arange(RET_HEADS, dtype=jnp.float32)))


def rotary(x, pos):
    half = RET_HEAD_DIM // 2
    inv = 1.0 / (ROPE_BASE ** jnp.linspace(0.0, 1.0, half, dtype=jnp.float32))
    ang = pos.astype(jnp.float32)[:, None] * inv[None, :]
    cos = jnp.cos(ang)[None, :, None, :]
    sin = jnp.sin(ang)[None, :, None, :]
    x1, x2 = x[..., :half], x[..., half:]
    return jnp.concatenate([x1 * cos - x2 * sin, x1 * sin + x2 * cos], axis=-1)


def retention_chunkwise(q, k, v):
    B, L, H, Dh = q.shape
    pad = CHUNK - N_META
    padf = lambda t: jnp.pad(t, ((0, 0), (pad, 0), (0, 0), (0, 0)))
    Lp = L + pad
    nc = Lp // CHUNK
    qc = padf(q).reshape(B, nc, CHUNK, H, Dh)
    kc = padf(k).reshape(B, nc, CHUNK, H, Dh)
    vc = padf(v).reshape(B, nc, CHUNK, H, Dh)
    lg = log_gammas()
    idx = jnp.arange(CHUNK, dtype=jnp.float32)
    diff = idx[:, None] - idx[None, :]
    mask = jnp.where(diff[None] >= 0, jnp.exp(lg[:, None, None] * jnp.maximum(diff, 0.0)[None]), 0.0)
    dec_end = jnp.exp(lg[:, None] * (CHUNK - 1 - idx)[None, :])
    dec_start = jnp.exp(lg[:, None] * (idx + 1.0)[None, :])
    chunk_dec = jnp.exp(lg * CHUNK)
    scores = jnp.einsum('bnihd,bnjhd->bnhij', qc, kc) * mask[None, None]
    o_intra = jnp.einsum('bnhij,bnjhe->bnihe', scores, vc)
    kv = jnp.einsum('bnjhd,bnjhe->bnhde', kc * dec_end.T[None, None, :, :, None], vc)

    def step(R, kv_n):
        return chunk_dec[None, :, None, None] * R + kv_n, R

    R_final, R_prev = lax.scan(step, jnp.zeros((B, H, Dh, Dh), jnp.float32), jnp.moveaxis(kv, 1, 0))
    R_prev = jnp.moveaxis(R_prev, 0, 1)
    o_inter = jnp.einsum('bnihd,bnhde->bnihe', qc, R_prev) * dec_start.T[None, None, :, :, None]
    o = (o_intra + o_inter).reshape(B, Lp, H, Dh)[:, pad:]
    return o, R_final


def retention_recurrent(q, k, v, S0):
    g = jnp.exp(log_gammas())[None, :, None, None]

    def step(S, qkv):
        q_t, k_t, v_t = qkv
        S = g * S + jnp.einsum('bhd,bhe->bhde', k_t, v_t)
        return S, jnp.einsum('bhd,bhde->bhe', q_t, S)

    S, o = lax.scan(step, S0, (jnp.moveaxis(q, 1, 0), jnp.moveaxis(k, 1, 0), jnp.moveaxis(v, 1, 0)))
    return jnp.moveaxis(o, 0, 1), S


def conformer_conv(a, b, buf, conv_w, conv_b, ln_g, ln_b):
    u = a * jax.nn.sigmoid(b)
    cat = jnp.concatenate([buf.astype(u.dtype), u], axis=1)
    y = lax.conv_general_dilated(cat, conv_w[:, None, :].astype(u.dtype), window_strides=(1,),
                                 padding='VALID', dimension_numbers=('NWC', 'WIO', 'NWC'),
                                 feature_group_count=CONV_CH) + conv_b
    new_buf = cat[:, -(CONV_WIDTH - 1):]
    y32 = y.astype(jnp.float32)
    mu = jnp.mean(y32, axis=-1, keepdims=True)
    var = jnp.mean(jnp.square(y32 - mu), axis=-1, keepdims=True)
    yn = (y32 - mu) * lax.rsqrt(var + EPS) * ln_g.astype(jnp.float32) + ln_b.astype(jnp.float32)
    return jax.nn.silu(yn).astype(a.dtype), new_buf


def layer(h, pos, ret_state, conv_buf, n_mix_pre, n_mix_post, n_ffn_pre, n_ffn_post,
          w_in, conv_w, conv_b, ln_g, ln_b, w_out, w_ffn_in, w_ffn_out):
    B, T, _ = h.shape
    xn = rms_norm(h, n_mix_pre)
    proj = xn @ w_in
    q, k, v, g, a, b = jnp.split(proj, [RET_W, 2 * RET_W, 3 * RET_W, 4 * RET_W, 4 * RET_W + CONV_CH], axis=-1)
    heads = lambda t: t.astype(jnp.float32).reshape(B, T, RET_HEADS, RET_HEAD_DIM)
    qh = rotary(heads(q), pos)
    kh = rotary(heads(k), pos) * (RET_HEAD_DIM ** -0.5)
    vh = heads(v)
    if ret_state is None:
        o, new_ret = retention_chunkwise(qh, kh, vh)
    else:
        o, new_ret = retention_recurrent(qh, kh, vh, ret_state.astype(jnp.float32))
    o = o * lax.rsqrt(jnp.mean(o * o, axis=-1, keepdims=True) + EPS)
    ret_out = (o.reshape(B, T, RET_W) * jax.nn.silu(g.astype(jnp.float32))).astype(h.dtype)
    conv_out, new_buf = conformer_conv(a, b, conv_buf, conv_w, conv_b, ln_g, ln_b)
    mix = jnp.concatenate([ret_out, conv_out], axis=-1) @ w_out
    h = h + rms_norm(mix, n_mix_post)
    xf = rms_norm(h, n_ffn_pre)
    gate, up = jnp.split(xf @ w_ffn_in, [D_FF], axis=-1)
    h = h + rms_norm((jax.nn.silu(gate) * up) @ w_ffn_out, n_ffn_post)
    return h, new_ret, new_buf


def setup_inputs(seed: int = 0) -> dict:
    key = jax.random.key(seed)
    ks = jax.random.split(key, 20)
    f32 = jnp.float32
    nrm = lambda k, shape, s: jax.random.normal(k, shape, f32) * s
    gain = lambda k: 1.0 + nrm(k, (DEPTH, D_MODEL), 0.05)
    return {
        "x_prompt": nrm(ks[0], (BATCH, SEQ, D_MODEL), 1.0),
        "x_sample": nrm(ks[1], (DEC_BATCH, DEC_SEQ, D_MODEL), 1.0),
        "state_ret": nrm(ks[2], (DEPTH, DEC_BATCH, RET_HEADS, RET_HEAD_DIM, RET_HEAD_DIM), 0.1),
        "state_conv": nrm(ks[3], (DEPTH, DEC_BATCH, CONV_WIDTH - 1, CONV_CH), 0.5),
        "meta_tokens": nrm(ks[4], (N_META, D_MODEL), 1.0),
        "norm_mix_pre": gain(ks[5]),
        "norm_mix_post": gain(ks[6]),
        "norm_ffn_pre": gain(ks[7]),
        "norm_ffn_post": gain(ks[8]),
        "w_in": nrm(ks[9], (DEPTH, D_MODEL, IN_COLS), D_MODEL ** -0.5),
        "conv_w": nrm(ks[10], (DEPTH, CONV_WIDTH, CONV_CH), CONV_WIDTH ** -0.5),
        "conv_b": nrm(ks[11], (DEPTH, CONV_CH), 0.02),
        "conv_ln_g": 1.0 + nrm(ks[12], (DEPTH, CONV_CH), 0.05),
        "conv_ln_b": nrm(ks[13], (DEPTH, CONV_CH), 0.02),
        "w_out": nrm(ks[14], (DEPTH, RET_W + CONV_CH, D_MODEL), (RET_W + CONV_CH) ** -0.5),
        "w_ffn_in": nrm(ks[15], (DEPTH, D_MODEL, 2 * D_FF), D_MODEL ** -0.5),
        "w_ffn_out": nrm(ks[16], (DEPTH, D_FF, D_MODEL), D_FF ** -0.5),
    }


def reference(x_prompt, x_sample, state_ret, state_conv, meta_tokens, norm_mix_pre, norm_mix_post,
              norm_ffn_pre, norm_ffn_post, w_in, conv_w, conv_b, conv_ln_g, conv_ln_b, w_out,
              w_ffn_in, w_ffn_out):
    B = x_prompt.shape[0]
    meta = jnp.broadcast_to(meta_tokens.astype(x_prompt.dtype)[None], (B, N_META, D_MODEL))
    hp = jnp.concatenate([meta, x_prompt], axis=1)
    pos_p = jnp.arange(SEQ + N_META)
    hs = x_sample
    pos_s = PAST_LEN + jnp.arange(x_sample.shape[1])
    ret_p_list, conv_p_list, ret_s_list, conv_s_list = [], [], [], []
    for l in range(DEPTH):
        lw = (norm_mix_pre[l], norm_mix_post[l], norm_ffn_pre[l], norm_ffn_post[l], w_in[l], conv_w[l],
              conv_b[l], conv_ln_g[l], conv_ln_b[l], w_out[l], w_ffn_in[l], w_ffn_out[l])
        zero_buf = jnp.zeros((B, CONV_WIDTH - 1, CONV_CH), hp.dtype)
        hp, r_p, c_p = layer(hp, pos_p, None, zero_buf, *lw)
        hs, r_s, c_s = layer(hs, pos_s, state_ret[l], state_conv[l], *lw)
        ret_p_list.append(r_p); conv_p_list.append(c_p)
        ret_s_list.append(r_s); conv_s_list.append(c_s)
    y_prompt = hp[:, N_META:]
    y_sample = hs
    ret_prompt = jnp.stack(ret_p_list)
    conv_prompt = jnp.stack(conv_p_list)
    ret_sample = jnp.stack(ret_s_list)
    conv_sample = jnp.stack(conv_s_list)
    return (y_prompt, y_sample, ret_prompt, conv_prompt, ret_sample, conv_sample)
```

```cpp
#include <hip/hip_runtime.h>
#include <hip/hip_cooperative_groups.h>
#include <cstdio>
#include <cstdint>
namespace cg = cooperative_groups;

#define LAS __attribute__((address_space(3)))
typedef unsigned short bf16_t;
typedef short bf16x8 __attribute__((ext_vector_type(8)));
typedef short s16x4 __attribute__((ext_vector_type(4)));
typedef float f32x4 __attribute__((ext_vector_type(4)));
typedef float f32x2 __attribute__((ext_vector_type(2)));
typedef unsigned u32x4 __attribute__((ext_vector_type(4)));
typedef unsigned u32x2 __attribute__((ext_vector_type(2)));

constexpr int D = 1024, NB = 8, SEQ = 2048, NS = 128, NMETA = 16, NH = 4, HD = 128, RW = 512, CC = 512, CW = 31, FF = 2816, INC = 3072;
constexpr int ROW_S = NB * SEQ;
constexpr int ROW_M = ROW_S + NS;
constexpr int ROW_E = ROW_M + NMETA;
constexpr int MP = 16640;
constexpr float EPS = 1e-6f;
constexpr size_t OFF_YS = (size_t)ROW_S * D, OFF_RETP = OFF_YS + (size_t)NS * D, OFF_CONVP = OFF_RETP + (size_t)NB * NH * HD * HD,
                 OFF_RETS = OFF_CONVP + (size_t)NB * 30 * CC, OFF_CONVS = OFF_RETS + (size_t)NS * NH * HD * HD;
constexpr size_t KiB = 1024, MiB = 1u << 20;
constexpr size_t WS_ROPE = 0;
constexpr size_t WS_W1T = 2 * MiB, WS_WOT = 8 * MiB, WS_W3T = 10 * MiB, WS_W4T = 21 * MiB;
constexpr size_t WS_XN = 26 * MiB + 512 * KiB;
constexpr size_t SZ_QS = (size_t)MP * 512 * 2;
constexpr size_t WS_Q = 59 * MiB, WS_K = WS_Q + SZ_QS, WS_V = WS_K + SZ_QS, WS_SG = WS_V + SZ_QS, WS_U = WS_SG + SZ_QS;
constexpr size_t WS_MIXIN = WS_U + SZ_QS;
constexpr size_t WS_KV = WS_MIXIN + (size_t)MP * 1024 * 2;
constexpr size_t WS_RP = WS_KV + (size_t)516 * 65536;
constexpr size_t WS_MIX = WS_RP + (size_t)512 * 32768;
constexpr size_t WS_ACT = WS_Q;
constexpr size_t WS_FFN = WS_KV;
constexpr size_t WS_END = WS_MIX + (size_t)MP * 1024 * 2;
static_assert(WS_END <= 256 * MiB, "ws");
static_assert(WS_ACT + (size_t)MP * FF * 2 <= WS_KV, "act overlay");
static_assert(WS_FFN + (size_t)MP * 1024 * 2 <= WS_MIX, "ffn overlay");
constexpr int LDS_BYTES = 147456;

__device__ __forceinline__ unsigned cvt_pk_bf16(float lo, float hi) { unsigned r; asm volatile("v_cvt_pk_bf16_f32 %0, %1, %2" : "=v"(r) : "v"(lo), "v"(hi)); return r; }
__device__ __forceinline__ float bf2f(unsigned short b) { return __uint_as_float(((unsigned)b) << 16); }
__device__ __forceinline__ float bflo(unsigned w) { return __uint_as_float(w << 16); }
__device__ __forceinline__ float bfhi(unsigned w) { return __uint_as_float(w & 0xffff0000u); }
__device__ __forceinline__ float wave_sum(float v) {
#pragma unroll
    for (int o = 1; o < 64; o <<= 1) v += __shfl_xor(v, o);
    return v;
}
__device__ __forceinline__ float silu_f(float x) { return x / (1.0f + __expf(-x)); }
__device__ __forceinline__ float lg2gamma(int h) { return log2f(1.0f - exp2f(-5.0f - (float)h)); }

namespace pg8 {
constexpr int BM = 256, BK = 64, HALF = 128, HTB = HALF * BK * 2, STAGE_BYTES = 8 * HTB, NXCD = 8, WGM = 8;
__device__ __forceinline__ int lds_byte(int r, int c) { const int st = (r >> 4) * 2 + (c >> 5), rr = r & 15, cc = c & 31, ob = rr * 64 + cc * 2; return st * 1024 + (ob ^ (((ob >> 9) & 1) << 5)); }
__device__ __forceinline__ void stage_rc(int b, int& R, int& C) { const int st = b / 1024, sb = b % 1024, swz = sb ^ (((sb >> 9) & 1) << 5); R = (st >> 1) * 16 + swz / 64; C = (st & 1) * 32 + (swz % 64) / 2; }
__device__ __forceinline__ int perm32(int rho) { const int n = rho >> 4, i = rho & 15; return 8 * (i >> 2) + 4 * n + (i & 3); }
struct Unit { int pm, pn; };
struct Gemm { const bf16_t* A; const bf16_t* Bt; int M, N, K; };
struct StaticOrder {
    int nM, nN, nwg, G, c;
    __device__ void init(int M, int N, int G_, int c_) { nM = M / BM; nN = N / BM; nwg = nM * nN; G = G_; c = c_; }
    __device__ bool next(int i, Unit& u) const {
        const long L = (long)i * G + c; if (L >= nwg) return false;
        int wgid = (int)L; { const int q = nwg / NXCD, r = nwg % NXCD, xcd = wgid % NXCD, off = wgid / NXCD; wgid = (xcd < r ? xcd * (q + 1) : r * (q + 1) + (xcd - r) * q) + off; }
        const int nig = WGM * nN, gid = wgid / nig, fm = gid * WGM, gsz = (nM - fm) < WGM ? (nM - fm) : WGM;
        u.pm = fm + ((wgid % nig) % gsz); u.pn = (wgid % nig) / gsz; return true;
    }
};

template <class Epi>
__device__ __forceinline__ void gemm_phase(LAS unsigned char* lds, const Gemm g, const StaticOrder& S, const Epi& E) {
    int tid_ = threadIdx.x; asm volatile("" : "+v"(tid_));
    const int tid = tid_, wid = __builtin_amdgcn_readfirstlane(tid >> 6), lane = tid & 63, wr = wid >> 2, wc = wid & 3, fr = lane & 15, fq = lane >> 4;
    const int K = g.K, nt = K / BK;
    unsigned voffA[2], voffB[2];
#pragma unroll
    for (int i = 0; i < 2; ++i) { int R, C; stage_rc(tid * 16 + i * 8192, R, C); const int Rb = ((R & ~31) + perm32(R & 31));
        voffA[i] = (unsigned)(R * K + C) * 2u; voffB[i] = (unsigned)(Rb * K + C) * 2u; }
    const size_t kstep = (size_t)(BK * 2);
    const size_t hstep = (size_t)HALF * K * 2;
    const size_t tstep = 2 * hstep;
    const unsigned ldsw = (unsigned)wid * 1024u;
    const int aoff = lds_byte(wr * 64 + fr, fq * 8), boff = lds_byte(wc * 32 + fr, fq * 8);
#define PG8_SA(b, h) (((b) * 2 + (h)) * HTB)
#define PG8_SB(b, h) ((4 + (b) * 2 + (h)) * HTB)
#define PG8_STAGE(bufoff, gbase, voff) do { _Pragma("unroll") for (int _i = 0; _i < 2; ++_i) \
        __builtin_amdgcn_global_load_lds((const unsigned*)((const char*)(gbase) + (voff)[_i]), (LAS unsigned*)(lds + (bufoff) + ldsw + _i * 8192), 16, 0, 0); } while (0)
#define PG8_LDA(dst, b, h) do { _Pragma("unroll") for (int m = 0; m < 4; ++m) _Pragma("unroll") for (int k = 0; k < 2; ++k) dst[m][k] = *(const LAS bf16x8*)(lds + PG8_SA(b, h) + aoff + m * 2048 + k * 1024); } while (0)
#define PG8_LDB(dst, b, h) do { _Pragma("unroll") for (int n = 0; n < 2; ++n) _Pragma("unroll") for (int k = 0; k < 2; ++k) dst[n][k] = *(const LAS bf16x8*)(lds + PG8_SB(b, h) + boff + n * 2048 + k * 1024); } while (0)
#define PG8_MMA(ai, bj, At, Bt) do { __builtin_amdgcn_s_setprio(1); _Pragma("unroll") for (int m = 0; m < 4; ++m) _Pragma("unroll") for (int n = 0; n < 2; ++n) _Pragma("unroll") for (int k = 0; k < 2; ++k) \
        acc[ai][bj][m][n] = __builtin_amdgcn_mfma_f32_16x16x32_bf16(Bt[n][k], At[m][k], acc[ai][bj][m][n], 0, 0, 0); __builtin_amdgcn_s_setprio(0); } while (0)
#define PG8_WAIT_V(n) asm volatile("s_waitcnt vmcnt(" #n ")" ::: "memory")
#define PG8_WAIT_L(n) asm volatile("s_waitcnt lgkmcnt(" #n ")" ::: "memory")
#define PG8_BAR __builtin_amdgcn_s_barrier()
#define PG8_SCHED __builtin_amdgcn_sched_barrier(0)
    Unit cur, nxt; int ui = 0;
    if (!S.next(0, cur)) return;
    f32x4 acc[2][2][4][2];
#pragma unroll
    for (int a = 0; a < 2; ++a)
#pragma unroll
        for (int b = 0; b < 2; ++b)
#pragma unroll
            for (int m = 0; m < 4; ++m)
#pragma unroll
                for (int n = 0; n < 2; ++n) acc[a][b][m][n] = (f32x4){0.f, 0.f, 0.f, 0.f};
    bf16x8 At[4][2], B0[2][2], B1[2][2];
    const char* cA = (const char*)g.A + (size_t)cur.pm * tstep; const char* cB = (const char*)g.Bt + (size_t)cur.pn * tstep;
    PG8_STAGE(PG8_SB(0, 0), cB, voffB); PG8_STAGE(PG8_SB(0, 1), cB + hstep, voffB); PG8_STAGE(PG8_SA(0, 0), cA, voffA); PG8_STAGE(PG8_SA(0, 1), cA + hstep, voffA);
    if (wr == 1) PG8_BAR;
    PG8_WAIT_V(2); PG8_BAR;
    PG8_STAGE(PG8_SB(1, 0), cB + kstep, voffB); PG8_STAGE(PG8_SA(1, 0), cA + kstep, voffA); PG8_STAGE(PG8_SB(1, 1), cB + hstep + kstep, voffB);
    PG8_WAIT_V(6); PG8_BAR;
    for (;;) {
        const bool has_next = S.next(ui + 1, nxt);
        const char* nA = has_next ? (const char*)g.A + (size_t)nxt.pm * tstep : cA; const char* nB = has_next ? (const char*)g.Bt + (size_t)nxt.pn * tstep : cB;
        for (int t = 0; t < nt; t += 2) {
            const bool last = (t == nt - 2);
            const char* a1 = cA + (size_t)(t + 1) * kstep;
            const char* a2 = last ? nA : cA + (size_t)(t + 2) * kstep; const char* b2 = last ? nB : cB + (size_t)(t + 2) * kstep;
            const char* a3 = a2 + kstep; const char* b3 = b2 + kstep;
            PG8_LDB(B0, 0, 0); PG8_LDB(B1, 0, 1); PG8_SCHED; PG8_LDA(At, 0, 0); PG8_STAGE(PG8_SA(1, 1), a1 + hstep, voffA);
            PG8_WAIT_V(8); PG8_WAIT_L(0); PG8_BAR; PG8_MMA(0, 0, At, B0); PG8_MMA(0, 1, At, B1); PG8_BAR; PG8_SCHED;
            PG8_LDA(At, 0, 1); PG8_STAGE(PG8_SB(0, 0), b2, voffB); PG8_STAGE(PG8_SB(0, 1), b2 + hstep, voffB); PG8_STAGE(PG8_SA(0, 0), a2, voffA);
            PG8_WAIT_V(8); PG8_WAIT_L(0); PG8_BAR; PG8_MMA(1, 0, At, B0); PG8_MMA(1, 1, At, B1); PG8_BAR; PG8_SCHED;
            PG8_LDB(B0, 1, 0); PG8_LDB(B1, 1, 1); PG8_SCHED; PG8_LDA(At, 1, 0); PG8_STAGE(PG8_SA(0, 1), a2 + hstep, voffA);
            PG8_WAIT_V(8); PG8_WAIT_L(0); PG8_BAR; PG8_MMA(0, 0, At, B0); PG8_MMA(0, 1, At, B1); PG8_BAR; PG8_SCHED;
            PG8_LDA(At, 1, 1); PG8_STAGE(PG8_SB(1, 0), b3, voffB); PG8_STAGE(PG8_SB(1, 1), b3 + hstep, voffB); PG8_STAGE(PG8_SA(1, 0), a3, voffA);
            PG8_WAIT_V(8); PG8_WAIT_L(0); PG8_BAR; PG8_MMA(1, 0, At, B0); PG8_MMA(1, 1, At, B1); PG8_BAR; PG8_SCHED;
        }
        if (wr == 0) PG8_BAR;
        E(acc, cur, wr, wc, fr, fq);
        if (!has_next) break;
#pragma unroll
        for (int a = 0; a < 2; ++a)
#pragma unroll
            for (int b = 0; b < 2; ++b)
#pragma unroll
                for (int m = 0; m < 4; ++m)
#pragma unroll
                    for (int n = 0; n < 2; ++n) acc[a][b][m][n] = (f32x4){0.f, 0.f, 0.f, 0.f};
        cur = nxt; cA = nA; cB = nB; ++ui;
        if (wr == 1) PG8_BAR;
    }
    PG8_WAIT_V(0);
    PG8_BAR;
#undef PG8_SA
#undef PG8_SB
#undef PG8_STAGE
#undef PG8_LDA
#undef PG8_LDB
#undef PG8_MMA
#undef PG8_WAIT_V
#undef PG8_WAIT_L
#undef PG8_BAR
#undef PG8_SCHED
}
}

__device__ __forceinline__ u32x4 pack8(const f32x4 a, const f32x4 b) { u32x4 w; w.x = cvt_pk_bf16(a[0], a[1]); w.y = cvt_pk_bf16(a[2], a[3]); w.z = cvt_pk_bf16(b[0], b[1]); w.w = cvt_pk_bf16(b[2], b[3]); return w; }

struct EpiPlain {
    bf16_t* O; int ldc;
    __device__ __forceinline__ void operator()(const f32x4 (&acc)[2][2][4][2], const pg8::Unit& u, int wr, int wc, int fr, int fq) const {
        const int row0 = u.pm * 256 + wr * 64 + fr, col0 = u.pn * 256 + wc * 32 + 8 * fq;
#pragma unroll
        for (int ai = 0; ai < 2; ++ai)
#pragma unroll
            for (int m = 0; m < 4; ++m) { bf16_t* rowp = O + (size_t)(row0 + ai * 128 + m * 16) * ldc + col0;
#pragma unroll
                for (int bj = 0; bj < 2; ++bj) *(u32x4*)(rowp + bj * 128) = pack8(acc[ai][bj][m][0], acc[ai][bj][m][1]); }
    }
};
struct EpiGlu {
    bf16_t* O;
    __device__ __forceinline__ void operator()(const f32x4 (&acc)[2][2][4][2], const pg8::Unit& u, int wr, int wc, int fr, int fq) const {
        const int row0 = u.pm * 256 + wr * 64 + fr, col0 = u.pn * 128 + wc * 32 + 8 * fq;
#pragma unroll
        for (int ai = 0; ai < 2; ++ai)
#pragma unroll
            for (int m = 0; m < 4; ++m) { bf16_t* rowp = O + (size_t)(row0 + ai * 128 + m * 16) * FF + col0;
                f32x4 o0, o1;
#pragma unroll
                for (int j = 0; j < 4; ++j) { o0[j] = silu_f(acc[ai][0][m][0][j]) * acc[ai][1][m][0][j]; o1[j] = silu_f(acc[ai][0][m][1][j]) * acc[ai][1][m][1][j]; }
                *(u32x4*)rowp = pack8(o0, o1); }
    }
};
struct EpiProj {
    bf16_t *Q, *Kb, *V, *SG, *U; const f32x2* rope; float* out;
    __device__ __forceinline__ void operator()(const f32x4 (&acc)[2][2][4][2], const pg8::Unit& u, int wr, int wc, int fr, int fq) const {
        const int pn = u.pn, jj0 = wc * 32 + 8 * fq;
        if (pn < 4) {
            const int sec = pn >> 1, head = (pn & 1) * 2 + (wc >> 1), dlow = (wc & 1) * 32 + 8 * fq;
            const float lg2 = lg2gamma(head);
            bf16_t* dst = sec ? Kb : Q;
#pragma unroll
            for (int ai = 0; ai < 2; ++ai)
#pragma unroll
                for (int m = 0; m < 4; ++m) {
                    const int r = u.pm * 256 + ai * 128 + wr * 64 + m * 16 + fr;
                    int pidx, li;
                    if (r < ROW_S) { pidx = 16 + (r & 2047); li = r & 127; }
                    else if (r < ROW_M) { pidx = 2064; li = 0; }
                    else if (r < ROW_E) { pidx = r - ROW_M; li = 112 + pidx; }
                    else { pidx = 0; li = 0; }
                    const float sc = sec ? 0.08838834764831845f * exp2f(-lg2 * (float)li) : exp2f(lg2 * (float)li);
                    const f32x4* rp = (const f32x4*)(rope + (size_t)pidx * 64 + dlow);
                    const f32x4 cs0 = rp[0], cs1 = rp[1], cs2 = rp[2], cs3 = rp[3];
                    const f32x4 x1a = acc[ai][0][m][0], x1b = acc[ai][0][m][1], x2a = acc[ai][1][m][0], x2b = acc[ai][1][m][1];
                    f32x4 o1a, o1b, o2a, o2b;
                    o1a[0] = (x1a[0] * cs0[0] - x2a[0] * cs0[1]) * sc; o2a[0] = (x1a[0] * cs0[1] + x2a[0] * cs0[0]) * sc;
                    o1a[1] = (x1a[1] * cs0[2] - x2a[1] * cs0[3]) * sc; o2a[1] = (x1a[1] * cs0[3] + x2a[1] * cs0[2]) * sc;
                    o1a[2] = (x1a[2] * cs1[0] - x2a[2] * cs1[1]) * sc; o2a[2] = (x1a[2] * cs1[1] + x2a[2] * cs1[0]) * sc;
                    o1a[3] = (x1a[3] * cs1[2] - x2a[3] * cs1[3]) * sc; o2a[3] = (x1a[3] * cs1[3] + x2a[3] * cs1[2]) * sc;
                    o1b[0] = (x1b[0] * cs2[0] - x2b[0] * cs2[1]) * sc; o2b[0] = (x1b[0] * cs2[1] + x2b[0] * cs2[0]) * sc;
                    o1b[1] = (x1b[1] * cs2[2] - x2b[1] * cs2[3]) * sc; o2b[1] = (x1b[1] * cs2[3] + x2b[1] * cs2[2]) * sc;
                    o1b[2] = (x1b[2] * cs3[0] - x2b[2] * cs3[1]) * sc; o2b[2] = (x1b[2] * cs3[1] + x2b[2] * cs3[0]) * sc;
                    o1b[3] = (x1b[3] * cs3[2] - x2b[3] * cs3[3]) * sc; o2b[3] = (x1b[3] * cs3[3] + x2b[3] * cs3[2]) * sc;
                    bf16_t* rowp = dst + (size_t)r * 512 + head * 128 + dlow;
                    *(u32x4*)rowp = pack8(o1a, o1b);
                    *(u32x4*)(rowp + 64) = pack8(o2a, o2b);
                }
        } else if (pn < 8) {
            bf16_t* dst = pn < 6 ? V : SG; const bool act = pn >= 6;
            const int colt = (pn & 1) * 256 + jj0;
#pragma unroll
            for (int ai = 0; ai < 2; ++ai)
#pragma unroll
                for (int m = 0; m < 4; ++m) {
                    const int r = u.pm * 256 + ai * 128 + wr * 64 + m * 16 + fr;
#pragma unroll
                    for (int bj = 0; bj < 2; ++bj) {
                        f32x4 a = acc[ai][bj][m][0], b = acc[ai][bj][m][1];
                        if (act) {
#pragma unroll
                            for (int j = 0; j < 4; ++j) { a[j] = silu_f(a[j]); b[j] = silu_f(b[j]); } }
                        *(u32x4*)(dst + (size_t)r * 512 + colt + bj * 128) = pack8(a, b); }
                }
        } else {
            const int c0 = (pn - 8) * 128 + jj0;
#pragma unroll
            for (int ai = 0; ai < 2; ++ai)
#pragma unroll
                for (int m = 0; m < 4; ++m) {
                    const int r = u.pm * 256 + ai * 128 + wr * 64 + m * 16 + fr;
                    f32x4 o0, o1;
#pragma unroll
                    for (int j = 0; j < 4; ++j) { o0[j] = acc[ai][0][m][0][j] / (1.0f + __expf(-acc[ai][1][m][0][j])); o1[j] = acc[ai][0][m][1][j] / (1.0f + __expf(-acc[ai][1][m][1][j])); }
                    *(u32x4*)(U + (size_t)r * 512 + c0) = pack8(o0, o1);
                    if (r < ROW_S) { const int s = r & 2047; if (s >= SEQ - 30) { float* p = out + OFF_CONVP + ((size_t)((r >> 11) * 30 + (s - (SEQ - 30))) * 512 + c0); *(f32x4*)p = o0; *(f32x4*)(p + 4) = o1; } }
                    else if (r < ROW_M) { float* p = out + OFF_CONVS + ((size_t)((r - ROW_S) * 30 + 29) * 512 + c0); *(f32x4*)p = o0; *(f32x4*)(p + 4) = o1; }
                }
        }
    }
};

__device__ __forceinline__ int src_w1(int n) {
    const int pn = n >> 8, j = n & 255, bj = j >> 7, jj = j & 127;
    if (pn < 4) { const int sec = pn >> 1, head = (pn & 1) * 2 + (jj >> 6), d = (jj & 63) + 64 * bj; return sec * 512 + head * 128 + d; }
    if (pn < 8) return n;
    return 2048 + 512 * bj + 128 * (pn - 8) + jj;
}
__device__ __forceinline__ int src_w3(int n) { const int pn = n >> 8, j = n & 255, bj = j >> 7, jj = j & 127; return FF * bj + 128 * pn + jj; }
template <int MODE>
__device__ __forceinline__ void p0_transpose_item(const float* W, int K, int N, bf16_t* WT, LAS float* scr, int item, int lane) {
    const int nblk = N / 32, kb = item / nblk, nb = item % nblk, k0 = 64 * kb, n0 = 32 * nb;
    const int s0 = MODE == 1 ? src_w1(n0) : MODE == 2 ? src_w3(n0) : n0;
#pragma unroll 8
    for (int i = 0; i < 32; ++i) { const int kk = 2 * i + (lane >> 5); scr[kk * 33 + (lane & 31)] = W[(size_t)(k0 + kk) * N + s0 + (lane & 31)]; }
    asm volatile("s_waitcnt lgkmcnt(0)" ::: "memory");
    const int c = lane & 7;
#pragma unroll
    for (int j = 0; j < 4; ++j) { const int n = (lane >> 3) + 8 * j; const LAS float* s = scr + (8 * c) * 33 + n;
        u32x4 o; o.x = cvt_pk_bf16(s[0 * 33], s[1 * 33]); o.y = cvt_pk_bf16(s[2 * 33], s[3 * 33]); o.z = cvt_pk_bf16(s[4 * 33], s[5 * 33]); o.w = cvt_pk_bf16(s[6 * 33], s[7 * 33]);
        *(u32x4*)(WT + (size_t)(n0 + n) * K + k0 + 8 * c) = o; }
    asm volatile("s_waitcnt lgkmcnt(0)" ::: "memory");
}
__device__ __forceinline__ void sincos_acc(float angf, float& s, float& c) {
    const double a = (double)angf; const double n = rint(a * 0.15915494309189535);
    double r = fma(-n, 6.283185307179586, a); r = fma(-n, 2.4492935982947064e-16, r);
    const double h = 0.5 * r, h2 = h * h;
    double sp = -1.0 / 1307674368000.0; sp = sp * h2 + 1.0 / 6227020800.0; sp = sp * h2 - 1.0 / 39916800.0; sp = sp * h2 + 1.0 / 362880.0; sp = sp * h2 - 1.0 / 5040.0; sp = sp * h2 + 1.0 / 120.0; sp = sp * h2 - 1.0 / 6.0; sp = sp * h2 + 1.0;
    const double sh = sp * h;
    double cp = 1.0 / 20922789888000.0; cp = cp * h2 - 1.0 / 87178291200.0; cp = cp * h2 + 1.0 / 479001600.0; cp = cp * h2 - 1.0 / 3628800.0; cp = cp * h2 + 1.0 / 40320.0; cp = cp * h2 - 1.0 / 720.0; cp = cp * h2 + 1.0 / 24.0; cp = cp * h2 - 0.5; cp = cp * h2 + 1.0;
    s = (float)(2.0 * sh * cp); c = (float)(1.0 - 2.0 * sh * sh);
}
__device__ __forceinline__ void rms_row_to_bf16(const float* xrow, const float* w, bf16_t* orow, int lane) {
    const f32x4* xr = (const f32x4*)xrow + lane; const f32x4* wr4 = (const f32x4*)w + lane;
    f32x4 v[4]; float s = 0.f;
#pragma unroll
    for (int j = 0; j < 4; ++j) { v[j] = xr[64 * j]; s += (v[j].x * v[j].x + v[j].y * v[j].y) + (v[j].z * v[j].z + v[j].w * v[j].w); }
    const float rstd = 1.0f / sqrtf(wave_sum(s) * (1.f / D) + EPS);
    u32x2* o8 = (u32x2*)orow + lane;
#pragma unroll
    for (int j = 0; j < 4; ++j) { const f32x4 g = wr4[64 * j]; u32x2 o; o.x = cvt_pk_bf16(v[j].x * rstd * g.x, v[j].y * rstd * g.y); o.y = cvt_pk_bf16(v[j].z * rstd * g.z, v[j].w * rstd * g.w); o8[64 * j] = o; }
}

__device__ __forceinline__ unsigned off_b(unsigned row, unsigned ch) { return 256u * row + 16u * (ch ^ (((row & 3) << 2) | ((row >> 2) & 3))); }
__device__ __forceinline__ void load_tile128(LAS unsigned char* img, const bf16_t* g, size_t pitch, int tid, int zrows) {
#pragma unroll
    for (int i = 0; i < 4; ++i) { const int n = tid + 512 * i, row = n >> 4, ch = n & 15;
        u32x4 v = (u32x4){0u, 0u, 0u, 0u};
        if (row >= zrows) v = *(const u32x4*)(g + (size_t)(row - zrows) * pitch + ch * 8);
        *(LAS u32x4*)(img + off_b(row, ch)) = v; }
}
__device__ __forceinline__ bf16x8 tr_read2(unsigned a0, unsigned a1) {
    s16x4 r0, r1;
    asm volatile("ds_read_b64_tr_b16 %0, %2\n\tds_read_b64_tr_b16 %1, %3\n\ts_waitcnt lgkmcnt(0)" : "=&v"(r0), "=&v"(r1) : "v"(a0), "v"(a1) : "memory");
    bf16x8 o; o[0] = r0[0]; o[1] = r0[1]; o[2] = r0[2]; o[3] = r0[3]; o[4] = r1[0]; o[5] = r1[1]; o[6] = r1[2]; o[7] = r1[3]; return o;
}

__device__ __forceinline__ void kv_compute(LAS unsigned char* lds, float* dst, float scale, int w, int lane) {
    const unsigned bK = (unsigned)(uintptr_t)lds, bV = bK + 32768u;
    const unsigned g = lane >> 4, q = (lane & 15) >> 2, p = lane & 3;
    bf16x8 Kf[4];
#pragma unroll
    for (int ks = 0; ks < 4; ++ks) Kf[ks] = tr_read2(bK + off_b(32 * ks + 8 * g + q, 2 * w + (p >> 1)) + 8 * (p & 1), bK + off_b(32 * ks + 8 * g + 4 + q, 2 * w + (p >> 1)) + 8 * (p & 1));
#pragma unroll
    for (int et = 0; et < 8; ++et) {
        f32x4 acc = (f32x4){0.f, 0.f, 0.f, 0.f};
#pragma unroll
        for (int ks = 0; ks < 4; ++ks) {
            const bf16x8 Vf = tr_read2(bV + off_b(32 * ks + 8 * g + q, 2 * et + (p >> 1)) + 8 * (p & 1), bV + off_b(32 * ks + 8 * g + 4 + q, 2 * et + (p >> 1)) + 8 * (p & 1));
            acc = __builtin_amdgcn_mfma_f32_16x16x32_bf16(Vf, Kf[ks], acc, 0, 0, 0);
        }
        *(f32x4*)(dst + (size_t)(16 * w + (lane & 15)) * 128 + 16 * et + 4 * g) = acc * scale;
    }
}

__device__ __forceinline__ void ln8_stats(const float (&y)[8], float (&mu)[8], float (&rs)[8], LAS f32x2* red, int w, int lane) {
#pragma unroll
    for (int t = 0; t < 8; ++t) { const float s = wave_sum(y[t]), qq = wave_sum(y[t] * y[t]); if (lane == 0) red[w * 8 + t] = (f32x2){s, qq}; }
    __syncthreads();
#pragma unroll
    for (int t = 0; t < 8; ++t) { float s = 0.f, qq = 0.f;
#pragma unroll
        for (int ww = 0; ww < 8; ++ww) { const f32x2 v = red[ww * 8 + t]; s += v.x; qq += v.y; }
        const float m = s * (1.f / CC); float var = qq * (1.f / CC) - m * m; var = var < 0.f ? 0.f : var; mu[t] = m; rs[t] = 1.0f / sqrtf(var + EPS); }
    __syncthreads();
}

struct Args { const float* in[17]; float* out; unsigned char* ws; };

__global__ void __launch_bounds__(512, 2) mk_fwd(Args a) {
    extern __shared__ __attribute__((aligned(16))) unsigned char lds_raw[];
    LAS unsigned char* lds = (LAS unsigned char*)lds_raw;
    cg::grid_group grid = cg::this_grid();
#define PHASE_IDS int tid = threadIdx.x; asm volatile("" : "+v"(tid)); const int lane = tid & 63, w = __builtin_amdgcn_readfirstlane(tid >> 6); (void)lane; (void)w;
    const int G = gridDim.x, bx = blockIdx.x;
    unsigned char* ws = a.ws; float* out = a.out;
    const float* x_prompt = a.in[0]; const float* x_sample = a.in[1]; const float* state_ret = a.in[2]; const float* state_conv = a.in[3]; const float* meta = a.in[4];
    const float* g_mix_pre = a.in[5]; const float* g_mix_post = a.in[6]; const float* g_ffn_pre = a.in[7]; const float* g_ffn_post = a.in[8];
    const float* w_in = a.in[9]; const float* conv_w = a.in[10]; const float* conv_b = a.in[11]; const float* ln_g = a.in[12]; const float* ln_b = a.in[13];
    const float* w_out = a.in[14]; const float* w_ffn_in = a.in[15]; const float* w_ffn_out = a.in[16];
    f32x2* ROPE = (f32x2*)(ws + WS_ROPE);
    bf16_t* W1T = (bf16_t*)(ws + WS_W1T); bf16_t* WOT = (bf16_t*)(ws + WS_WOT); bf16_t* W3T = (bf16_t*)(ws + WS_W3T); bf16_t* W4T = (bf16_t*)(ws + WS_W4T);
    bf16_t* XN = (bf16_t*)(ws + WS_XN);
    bf16_t* Qb = (bf16_t*)(ws + WS_Q); bf16_t* Kb = (bf16_t*)(ws + WS_K); bf16_t* Vb = (bf16_t*)(ws + WS_V); bf16_t* SGb = (bf16_t*)(ws + WS_SG); bf16_t* Ub = (bf16_t*)(ws + WS_U);
    bf16_t* MIXIN = (bf16_t*)(ws + WS_MIXIN); float* KV = (float*)(ws + WS_KV); bf16_t* RP = (bf16_t*)(ws + WS_RP); bf16_t* MIX = (bf16_t*)(ws + WS_MIX);
    bf16_t* ACT = (bf16_t*)(ws + WS_ACT); bf16_t* FFN = (bf16_t*)(ws + WS_FFN);

    {
        PHASE_IDS
        LAS float* scr = (LAS float*)(lds + w * 16384);
        const int gw = bx * 8 + w, NGW = G * 8;
        constexpr int I1 = (D / 64) * (INC / 32), IO = (D / 64) * (D / 32), I3 = (D / 64) * (2 * FF / 32), I4 = (FF / 64) * (D / 32);
        for (int it = gw; it < I1 + IO + I3 + I4; it += NGW) {
            int r = it;
            if (r < I1) { p0_transpose_item<1>(w_in, D, INC, W1T, scr, r, lane); continue; } r -= I1;
            if (r < IO) { p0_transpose_item<0>(w_out, D, D, WOT, scr, r, lane); continue; } r -= IO;
            if (r < I3) { p0_transpose_item<2>(w_ffn_in, D, 2 * FF, W3T, scr, r, lane); continue; } r -= I3;
            p0_transpose_item<0>(w_ffn_out, FF, D, W4T, scr, r, lane);
        }
        for (int m = gw; m < MP; m += NGW) {
            bf16_t* orow = XN + (size_t)m * D;
            if (m < ROW_S) rms_row_to_bf16(x_prompt + (size_t)m * D, g_mix_pre, orow, lane);
            else if (m < ROW_M) rms_row_to_bf16(x_sample + (size_t)(m - ROW_S) * D, g_mix_pre, orow, lane);
            else if (m < ROW_E) rms_row_to_bf16(meta + (size_t)(m - ROW_M) * D, g_mix_pre, orow, lane);
            else { u32x2* o8 = (u32x2*)orow + lane;
#pragma unroll
                for (int j = 0; j < 4; ++j) o8[64 * j] = (u32x2){0u, 0u}; }
        }
        for (int idx = bx * 512 + tid; idx < 2065 * 64; idx += G * 512) {
            const int pi = idx >> 6, j = idx & 63;
            const float posf = pi == 2064 ? 16384.f : (float)pi;
            const float lin = (float)j / 63.0f;
            const float pw = (float)exp2((double)lin * 13.287712379549449);
            const float inv = 1.0f / pw;
            float s, c; sincos_acc(posf * inv, s, c);
            ROPE[idx] = (f32x2){c, s};
        }
    }
    grid.sync();

    {
        pg8::Gemm g{XN, W1T, MP, INC, D}; pg8::StaticOrder S; S.init(MP, INC, G, bx);
        EpiProj E{Qb, Kb, Vb, SGb, Ub, ROPE, out};
        pg8::gemm_phase<EpiProj>(lds, g, S, E);
    }
    grid.sync();

    {
        PHASE_IDS
        constexpr int N_KV = 512, N_KVM = 4, N_SR = NS * NH, N_CP = ROW_S / 32, N_CS = NS / 8;
        constexpr int I_KVM = N_KV, I_SR = I_KVM + N_KVM, I_CP = I_SR + N_SR, I_CS = I_CP + N_CP, I_END = I_CS + N_CS;
        for (int it = bx; it < I_SR; it += G) {
            {
                const bool ismeta = it >= I_KVM;
                const int h = ismeta ? it - I_KVM : (it >> 4) & 3;
                const int row0 = ismeta ? ROW_M : (it >> 6) * SEQ + (it & 15) * 128;
                __syncthreads();
                load_tile128(lds, Kb + (size_t)row0 * 512 + h * 128, 512, tid, ismeta ? 112 : 0);
                load_tile128(lds + 32768, Vb + (size_t)row0 * 512 + h * 128, 512, tid, ismeta ? 112 : 0);
                __syncthreads();
                kv_compute(lds, KV + (size_t)it * 16384, exp2f(lg2gamma(h) * 127.f), w, lane);
            }
        }
        for (int it = I_SR + bx; it < I_CP; it += G) {
            {
                const int sr = it - I_SR, i = sr >> 2, h = sr & 3, r = ROW_S + i;
                const int e4 = tid & 31, dg = tid >> 5;
                const float gam = exp2f(lg2gamma(h));
                const float* S0 = state_ret + (size_t)sr * 16384; float* S1 = out + OFF_RETS + (size_t)sr * 16384;
                const u32x2 vv = *(const u32x2*)(Vb + (size_t)r * 512 + h * 128 + 4 * e4);
                const f32x4 v4 = (f32x4){bflo(vv.x), bfhi(vv.x), bflo(vv.y), bfhi(vv.y)};
                f32x4 oacc = (f32x4){0.f, 0.f, 0.f, 0.f};
#pragma unroll
                for (int ii = 0; ii < 8; ++ii) { const int d = dg + 16 * ii;
                    const float kd = bf2f(Kb[(size_t)r * 512 + h * 128 + d]), qd = bf2f(Qb[(size_t)r * 512 + h * 128 + d]);
                    f32x4 s = *(const f32x4*)(S0 + d * 128 + 4 * e4);
                    s = s * gam + v4 * kd;
                    *(f32x4*)(S1 + d * 128 + 4 * e4) = s;
                    oacc += s * qd; }
                LAS float* red = (LAS float*)lds;
                __syncthreads();
                *(LAS f32x4*)(red + dg * 128 + 4 * e4) = oacc;
                __syncthreads();
                if (tid < 128) { float o = 0.f;
#pragma unroll
                    for (int k = 0; k < 16; ++k) o += red[k * 128 + tid];
                    const float ss = wave_sum(o * o);
                    if (lane == 0) red[2048 + w] = ss;
                    red[2304 + tid] = o; }
                __syncthreads();
                if (tid < 128) { const float ss = red[2048] + red[2049]; const float o = red[2304 + tid] * (1.0f / sqrtf(ss * (1.f / HD) + EPS));
                    const float sg = bf2f(SGb[(size_t)r * 512 + h * 128 + tid]);
                    MIXIN[(size_t)r * 1024 + h * 128 + tid] = (bf16_t)(cvt_pk_bf16(o * sg, 0.f) & 0xffffu); }
            }
        }
        for (int it = I_CP + bx; it < I_CS; it += G) {
            {
                const int ct = it - I_CP, b = ct >> 6, s0 = (ct & 63) * 32;
                LAS bf16_t* ub = (LAS bf16_t*)lds;
                LAS f32x2* red = (LAS f32x2*)(lds + 65536);
                __syncthreads();
                for (int n = tid; n < 62 * 64; n += 512) { const int rho = n >> 6, ch = n & 63; const int P = 16 + s0 - 30 + rho;
                    u32x4 v = (u32x4){0u, 0u, 0u, 0u};
                    if (P >= 0) { const int row = P < 16 ? ROW_M + P : b * SEQ + P - 16; v = *(const u32x4*)(Ub + (size_t)row * 512 + ch * 8); }
                    *(LAS u32x4*)(ub + rho * 512 + ch * 8) = v; }
                float wj[31];
#pragma unroll
                for (int j = 0; j < 31; ++j) wj[j] = conv_w[j * 512 + tid];
                const float cb = conv_b[tid], lg = ln_g[tid], lb = ln_b[tid];
                __syncthreads();
                for (int grp = 0; grp < 4; ++grp) {
                    float win[38];
#pragma unroll
                    for (int k = 0; k < 38; ++k) win[k] = bf2f(ub[(grp * 8 + k) * 512 + tid]);
                    float y[8];
#pragma unroll
                    for (int t = 0; t < 8; ++t) { float acc = cb;
#pragma unroll
                        for (int j = 0; j < 31; ++j) acc += wj[j] * win[t + j];
                        y[t] = acc; }
                    float mu[8], rs[8]; ln8_stats(y, mu, rs, red, w, lane);
#pragma unroll
                    for (int t = 0; t < 8; ++t) { const float yn = (y[t] - mu[t]) * rs[t] * lg + lb; const int row = b * SEQ + s0 + grp * 8 + t;
                        MIXIN[(size_t)row * 1024 + 512 + tid] = (bf16_t)(cvt_pk_bf16(silu_f(yn), 0.f) & 0xffffu); }
                }
            }
        }
        for (int it = I_CS + bx; it < I_END; it += G) {
            {
                const int i0 = (it - I_CS) * 8;
                LAS f32x2* red = (LAS f32x2*)(lds + 65536);
                float wj[31];
#pragma unroll
                for (int j = 0; j < 31; ++j) wj[j] = conv_w[j * 512 + tid];
                const float cb = conv_b[tid], lg = ln_g[tid], lb = ln_b[tid];
                LAS float* ybuf = (LAS float*)lds;
                __syncthreads();
#pragma unroll 1
                for (int t = 0; t < 8; ++t) { const int i = i0 + t; float acc = cb;
                    const float* bufp = state_conv + (size_t)i * 30 * 512 + tid; float* op = out + OFF_CONVS + (size_t)i * 30 * 512 + tid;
#pragma unroll
                    for (int j = 0; j < 30; ++j) { const float bv = bufp[j * 512]; acc += wj[j] * bv; if (j >= 1) op[(j - 1) * 512] = bv; }
                    acc += wj[30] * bf2f(Ub[(size_t)(ROW_S + i) * 512 + tid]);
                    ybuf[t * 512 + tid] = acc; }
                float y[8];
#pragma unroll
                for (int t = 0; t < 8; ++t) y[t] = ybuf[t * 512 + tid];
                float mu[8], rs[8]; ln8_stats(y, mu, rs, red, w, lane);
#pragma unroll
                for (int t = 0; t < 8; ++t) { const float yn = (y[t] - mu[t]) * rs[t] * lg + lb;
                    MIXIN[(size_t)(ROW_S + i0 + t) * 1024 + 512 + tid] = (bf16_t)(cvt_pk_bf16(silu_f(yn), 0.f) & 0xffffu); }
            }
        }
    }
    grid.sync();

    {
        PHASE_IDS
        for (int idx = bx * 512 + tid; idx < 32 * 4096; idx += G * 512) {
            const int bh = idx >> 12, rem = idx & 4095, h = bh & 3;
            const float lg2 = lg2gamma(h), gam = exp2f(lg2), Gam = exp2f(lg2 * 128.f);
            f32x4 R = *(const f32x4*)(KV + (size_t)(512 + h) * 16384 + rem * 4);
            for (int c = 0; c < 16; ++c) {
                const f32x4 rs = R * gam; u32x2 o; o.x = cvt_pk_bf16(rs[0], rs[1]); o.y = cvt_pk_bf16(rs[2], rs[3]);
                *(u32x2*)(RP + (size_t)(bh * 16 + c) * 16384 + rem * 4) = o;
                R = R * Gam + *(const f32x4*)(KV + (size_t)(bh * 16 + c) * 16384 + rem * 4);
            }
            *(f32x4*)(out + OFF_RETP + (size_t)bh * 16384 + rem * 4) = R;
        }
    }
    grid.sync();

    {
        PHASE_IDS
        const unsigned bQ = (unsigned)(uintptr_t)lds, bKi = bQ + 32768u, bV = bQ + 65536u, bR = bQ + 98304u;
        const unsigned g = lane >> 4, q = (lane & 15) >> 2, p = lane & 3, fr = lane & 15;
        for (int it = bx; it < 512; it += G) {
            const int b = it >> 6, h = (it >> 4) & 3, c = it & 15;
            const int row0 = b * SEQ + c * 128;
            __syncthreads();
            load_tile128(lds, Qb + (size_t)row0 * 512 + h * 128, 512, tid, 0);
            load_tile128(lds + 32768, Kb + (size_t)row0 * 512 + h * 128, 512, tid, 0);
            load_tile128(lds + 65536, Vb + (size_t)row0 * 512 + h * 128, 512, tid, 0);
            load_tile128(lds + 98304, RP + (size_t)it * 16384, 128, tid, 0);
            __syncthreads();
            bf16x8 Qf[4];
#pragma unroll
            for (int s = 0; s < 4; ++s) Qf[s] = *(const LAS bf16x8*)(lds + off_b(fr + 16 * w, 4 * s + g));
            f32x4 accO[8];
#pragma unroll
            for (int et = 0; et < 8; ++et) {
                f32x4 acc = (f32x4){0.f, 0.f, 0.f, 0.f};
#pragma unroll
                for (int ks = 0; ks < 4; ++ks) {
                    const bf16x8 Rf = tr_read2(bR + off_b(32 * ks + 8 * g + q, 2 * et + (p >> 1)) + 8 * (p & 1), bR + off_b(32 * ks + 8 * g + 4 + q, 2 * et + (p >> 1)) + 8 * (p & 1));
                    acc = __builtin_amdgcn_mfma_f32_16x16x32_bf16(Rf, Qf[ks], acc, 0, 0, 0);
                }
                accO[et] = acc;
            }
            for (int jp = 0; 2 * jp <= w; ++jp) {
                const int ja = 2 * jp, jb = 2 * jp + 1;
                f32x4 sa = (f32x4){0.f, 0.f, 0.f, 0.f}, sb = (f32x4){0.f, 0.f, 0.f, 0.f};
#pragma unroll
                for (int s = 0; s < 4; ++s) { const bf16x8 Kf = *(const LAS bf16x8*)(lds + 32768 + off_b(fr + 16 * ja, 4 * s + g)); sa = __builtin_amdgcn_mfma_f32_16x16x32_bf16(Kf, Qf[s], sa, 0, 0, 0); }
                if (jb <= w) {
#pragma unroll
                    for (int s = 0; s < 4; ++s) { const bf16x8 Kf = *(const LAS bf16x8*)(lds + 32768 + off_b(fr + 16 * jb, 4 * s + g)); sb = __builtin_amdgcn_mfma_f32_16x16x32_bf16(Kf, Qf[s], sb, 0, 0, 0); }
                }
                if (ja == w) {
#pragma unroll
                    for (int rg = 0; rg < 4; ++rg) if (4 * g + rg > fr) sa[rg] = 0.f; }
                if (jb == w) {
#pragma unroll
                    for (int rg = 0; rg < 4; ++rg) if (4 * g + rg > fr) sb[rg] = 0.f; }
                bf16x8 Pf;
                { const unsigned p0 = cvt_pk_bf16(sa[0], sa[1]), p1 = cvt_pk_bf16(sa[2], sa[3]), p2 = cvt_pk_bf16(sb[0], sb[1]), p3 = cvt_pk_bf16(sb[2], sb[3]);
                  Pf[0] = (short)(p0 & 0xffff); Pf[1] = (short)(p0 >> 16); Pf[2] = (short)(p1 & 0xffff); Pf[3] = (short)(p1 >> 16);
                  Pf[4] = (short)(p2 & 0xffff); Pf[5] = (short)(p2 >> 16); Pf[6] = (short)(p3 & 0xffff); Pf[7] = (short)(p3 >> 16); }
#pragma unroll
                for (int et = 0; et < 8; ++et) {
                    const bf16x8 Vf = tr_read2(bV + off_b(32 * jp + 4 * g + q, 2 * et + (p >> 1)) + 8 * (p & 1), bV + off_b(32 * jp + 16 + 4 * g + q, 2 * et + (p >> 1)) + 8 * (p & 1));
                    accO[et] = __builtin_amdgcn_mfma_f32_16x16x32_bf16(Vf, Pf, accO[et], 0, 0, 0);
                }
            }
            float ss = 0.f;
#pragma unroll
            for (int et = 0; et < 8; ++et) ss += (accO[et][0] * accO[et][0] + accO[et][1] * accO[et][1]) + (accO[et][2] * accO[et][2] + accO[et][3] * accO[et][3]);
            ss += __shfl_xor(ss, 16); ss += __shfl_xor(ss, 32);
            const float rstd = 1.0f / sqrtf(ss * (1.f / HD) + EPS);
            const int row = row0 + 16 * w + fr;
#pragma unroll
            for (int et = 0; et < 8; ++et) {
                const u32x2 sg = *(const u32x2*)(SGb + (size_t)row * 512 + h * 128 + 16 * et + 4 * g);
                u32x2 o; o.x = cvt_pk_bf16(accO[et][0] * rstd * bflo(sg.x), accO[et][1] * rstd * bfhi(sg.x)); o.y = cvt_pk_bf16(accO[et][2] * rstd * bflo(sg.y), accO[et][3] * rstd * bfhi(sg.y));
                *(u32x2*)(MIXIN + (size_t)row * 1024 + h * 128 + 16 * et + 4 * g) = o;
            }
        }
        __syncthreads();
    }
    grid.sync();

    {
        pg8::Gemm g{MIXIN, WOT, MP, D, D}; pg8::StaticOrder S; S.init(MP, D, G, bx);
        EpiPlain E{MIX, D};
        pg8::gemm_phase<EpiPlain>(lds, g, S, E);
    }
    grid.sync();

    {
        PHASE_IDS
        const int gw = bx * 8 + w, NGW = G * 8;
        for (int m = gw; m < ROW_M; m += NGW) {
            const float* hrow = m < ROW_S ? x_prompt + (size_t)m * D : x_sample + (size_t)(m - ROW_S) * D;
            const f32x4* xr = (const f32x4*)hrow + lane; const u32x2* mr = (const u32x2*)(MIX + (size_t)m * D) + lane;
            f32x4 mv[4]; float s = 0.f;
#pragma unroll
            for (int j = 0; j < 4; ++j) { const u32x2 t = mr[64 * j]; mv[j] = (f32x4){bflo(t.x), bfhi(t.x), bflo(t.y), bfhi(t.y)}; s += (mv[j].x * mv[j].x + mv[j].y * mv[j].y) + (mv[j].z * mv[j].z + mv[j].w * mv[j].w); }
            const float rstd1 = 1.0f / sqrtf(wave_sum(s) * (1.f / D) + EPS);
            f32x4 hv[4]; float s2 = 0.f;
#pragma unroll
            for (int j = 0; j < 4; ++j) { const f32x4 gp = ((const f32x4*)g_mix_post + lane)[64 * j]; hv[j] = xr[64 * j] + mv[j] * rstd1 * gp;
                s2 += (hv[j].x * hv[j].x + hv[j].y * hv[j].y) + (hv[j].z * hv[j].z + hv[j].w * hv[j].w);
                ((f32x4*)(out + (size_t)m * D) + lane)[64 * j] = hv[j]; }
            const float rstd2 = 1.0f / sqrtf(wave_sum(s2) * (1.f / D) + EPS);
            u32x2* o8 = (u32x2*)(XN + (size_t)m * D) + lane;
#pragma unroll
            for (int j = 0; j < 4; ++j) { const f32x4 gp = ((const f32x4*)g_ffn_pre + lane)[64 * j]; u32x2 o; o.x = cvt_pk_bf16(hv[j].x * rstd2 * gp.x, hv[j].y * rstd2 * gp.y); o.y = cvt_pk_bf16(hv[j].z * rstd2 * gp.z, hv[j].w * rstd2 * gp.w); o8[64 * j] = o; }
        }
    }
    grid.sync();

    {
        pg8::Gemm g{XN, W3T, MP, 2 * FF, D}; pg8::StaticOrder S; S.init(MP, 2 * FF, G, bx);
        EpiGlu E{ACT};
        pg8::gemm_phase<EpiGlu>(lds, g, S, E);
    }
    grid.sync();

    {
        pg8::Gemm g{ACT, W4T, MP, D, FF}; pg8::StaticOrder S; S.init(MP, D, G, bx);
        EpiPlain E{FFN, D};
        pg8::gemm_phase<EpiPlain>(lds, g, S, E);
    }
    grid.sync();

    {
        PHASE_IDS
        const int gw = bx * 8 + w, NGW = G * 8;
        for (int m = gw; m < ROW_M; m += NGW) {
            const u32x2* fr2 = (const u32x2*)(FFN + (size_t)m * D) + lane;
            f32x4 fv[4]; float s = 0.f;
#pragma unroll
            for (int j = 0; j < 4; ++j) { const u32x2 t = fr2[64 * j]; fv[j] = (f32x4){bflo(t.x), bfhi(t.x), bflo(t.y), bfhi(t.y)}; s += (fv[j].x * fv[j].x + fv[j].y * fv[j].y) + (fv[j].z * fv[j].z + fv[j].w * fv[j].w); }
            const float rstd = 1.0f / sqrtf(wave_sum(s) * (1.f / D) + EPS);
            f32x4* orow = (f32x4*)(out + (size_t)m * D) + lane;
#pragma unroll
            for (int j = 0; j < 4; ++j) { const f32x4 gp = ((const f32x4*)g_ffn_post + lane)[64 * j]; orow[64 * j] = orow[64 * j] + fv[j] * rstd * gp; }
        }
    }
}

extern "C" void kernel_launch(void* const* d_in, const int* in_sizes, int n_in, void* d_out, int out_size, void* d_ws, size_t ws_size, hipStream_t stream) {
    static int grid = 0;
    if (grid == 0) {
        int dev = 0, cus = 0, per_cu = 0;
        hipGetDevice(&dev);
        hipDeviceGetAttribute(&cus, hipDeviceAttributeMultiprocessorCount, dev);
        hipFuncSetAttribute((const void*)mk_fwd, hipFuncAttributeMaxDynamicSharedMemorySize, LDS_BYTES);
        hipOccupancyMaxActiveBlocksPerMultiprocessor(&per_cu, (const void*)mk_fwd, 512, LDS_BYTES);
        if (per_cu < 1) per_cu = 1;
        grid = cus * per_cu;
        if (ws_size < WS_END || n_in != 17) { fprintf(stderr, "kernel_launch: unexpected ws %zu / n_in %d\n", ws_size, n_in); }
    }
    Args a{};
    for (int i = 0; i < 17; ++i) a.in[i] = (const float*)d_in[i];
    a.out = (float*)d_out; a.ws = (unsigned char*)d_ws;
    void* args[] = {&a};
    hipError_t e = hipLaunchCooperativeKernel((const void*)mk_fwd, dim3(grid), dim3(512), args, LDS_BYTES, stream);
    if (e != hipSuccess) fprintf(stderr, "cooperative launch failed: %s (grid %d)\n", hipGetErrorString(e), grid);
}
```

```cpp
#include <hip/hip_runtime.h>
#include <hip/hip_cooperative_groups.h>
#include <cstdio>
#include <cstdint>
namespace cg = cooperative_groups;

#define LAS __attribute__((address_space(3)))
typedef unsigned short bf16_t;
typedef short bf16x8 __attribute__((ext_vector_type(8)));
typedef short s16x4 __attribute__((ext_vector_type(4)));
typedef float f32x4 __attribute__((ext_vector_type(4)));
typedef float f32x2 __attribute__((ext_vector_type(2)));
typedef unsigned u32x4 __attribute__((ext_vector_type(4)));
typedef unsigned u32x2 __attribute__((ext_vector_type(2)));

constexpr int D = 1024, NB = 8, SEQ = 2048, NS = 128, NMETA = 16, NH = 4, HD = 128, RW = 512, CC = 512, CW = 31, FF = 2816, INC = 3072;
constexpr int ROW_S = NB * SEQ;
constexpr int ROW_M = ROW_S + NS;
constexpr int ROW_E = ROW_M + NMETA;
constexpr int MP = 16640;
constexpr float EPS = 1e-6f;
constexpr size_t OFF_YS = (size_t)ROW_S * D, OFF_RETP = OFF_YS + (size_t)NS * D, OFF_CONVP = OFF_RETP + (size_t)NB * NH * HD * HD,
                 OFF_RETS = OFF_CONVP + (size_t)NB * 30 * CC, OFF_CONVS = OFF_RETS + (size_t)NS * NH * HD * HD;
constexpr size_t KiB = 1024, MiB = 1u << 20;
constexpr size_t WS_ROPE = 0;
constexpr size_t WS_CTL = MiB + 512 * KiB, CTL_BYTES = 16384;
constexpr size_t WS_W1T = 2 * MiB, WS_WOT = 8 * MiB, WS_W3T = 10 * MiB, WS_W4T = 21 * MiB;
constexpr size_t WS_XN = 26 * MiB + 512 * KiB;
constexpr size_t SZ_QS = (size_t)MP * 512 * 2;
constexpr size_t WS_Q = 59 * MiB, WS_K = WS_Q + SZ_QS, WS_V = WS_K + SZ_QS, WS_SG = WS_V + SZ_QS, WS_U = WS_SG + SZ_QS;
constexpr size_t WS_MIXIN = WS_U + SZ_QS;
constexpr size_t WS_KV = WS_MIXIN + (size_t)MP * 1024 * 2;
constexpr size_t WS_RP = WS_KV + (size_t)516 * 65536;
constexpr size_t WS_MIX = WS_RP + (size_t)512 * 32768;
constexpr size_t WS_ACT = WS_Q;
constexpr size_t WS_FFN = WS_KV;
constexpr size_t WS_END = WS_MIX + (size_t)MP * 1024 * 2;
static_assert(WS_END <= 256 * MiB, "ws");
static_assert(WS_ACT + (size_t)MP * FF * 2 <= WS_KV, "act overlay");
static_assert(WS_FFN + (size_t)MP * 1024 * 2 <= WS_MIX, "ffn overlay");
constexpr int LDS_BYTES = 147456;

__device__ __forceinline__ unsigned cvt_pk_bf16(float lo, float hi) { unsigned r; asm volatile("v_cvt_pk_bf16_f32 %0, %1, %2" : "=v"(r) : "v"(lo), "v"(hi)); return r; }
__device__ __forceinline__ float bf2f(unsigned short b) { return __uint_as_float(((unsigned)b) << 16); }
__device__ __forceinline__ float bflo(unsigned w) { return __uint_as_float(w << 16); }
__device__ __forceinline__ float bfhi(unsigned w) { return __uint_as_float(w & 0xffff0000u); }
__device__ __forceinline__ float wave_sum(float v) {
#pragma unroll
    for (int o = 1; o < 64; o <<= 1) v += __shfl_xor(v, o);
    return v;
}
__device__ __forceinline__ float silu_f(float x) { return x / (1.0f + __expf(-x)); }
__device__ __forceinline__ float lg2gamma(int h) { return log2f(1.0f - exp2f(-5.0f - (float)h)); }

namespace pg8 {
constexpr int BM = 256, BK = 64, HALF = 128, HTB = HALF * BK * 2, STAGE_BYTES = 8 * HTB, NXCD = 8, WGM = 8;
__device__ __forceinline__ int lds_byte(int r, int c) { const int st = (r >> 4) * 2 + (c >> 5), rr = r & 15, cc = c & 31, ob = rr * 64 + cc * 2; return st * 1024 + (ob ^ (((ob >> 9) & 1) << 5)); }
__device__ __forceinline__ void stage_rc(int b, int& R, int& C) { const int st = b / 1024, sb = b % 1024, swz = sb ^ (((sb >> 9) & 1) << 5); R = (st >> 1) * 16 + swz / 64; C = (st & 1) * 32 + (swz % 64) / 2; }
__device__ __forceinline__ int perm32(int rho) { const int n = rho >> 4, i = rho & 15; return 8 * (i >> 2) + 4 * n + (i & 3); }
struct Unit { int pm, pn; };
struct Gemm { const bf16_t* A; const bf16_t* Bt; int M, N, K; };
struct StaticOrder {
    int nM, nN, nwg, G, c;
    __device__ void init(int M, int N, int G_, int c_) { nM = M / BM; nN = N / BM; nwg = nM * nN; G = G_; c = c_; }
    __device__ bool next(int i, Unit& u) const {
        const long L = (long)i * G + c; if (L >= nwg) return false;
        int wgid = (int)L; { const int q = nwg / NXCD, r = nwg % NXCD, xcd = wgid % NXCD, off = wgid / NXCD; wgid = (xcd < r ? xcd * (q + 1) : r * (q + 1) + (xcd - r) * q) + off; }
        const int nig = WGM * nN, gid = wgid / nig, fm = gid * WGM, gsz = (nM - fm) < WGM ? (nM - fm) : WGM;
        u.pm = fm + ((wgid % nig) % gsz); u.pn = (wgid % nig) / gsz; return true;
    }
};

template <class Epi>
__device__ __forceinline__ void gemm_phase(LAS unsigned char* lds, const Gemm g, const StaticOrder& S, const Epi& E) {
    int tid_ = threadIdx.x; asm volatile("" : "+v"(tid_));
    const int tid = tid_, wid = __builtin_amdgcn_readfirstlane(tid >> 6), lane = tid & 63, wr = wid >> 2, wc = wid & 3, fr = lane & 15, fq = lane >> 4;
    const int K = g.K, nt = K / BK;
    unsigned voffA[2], voffB[2];
#pragma unroll
    for (int i = 0; i < 2; ++i) { int R, C; stage_rc(tid * 16 + i * 8192, R, C); const int Rb = ((R & ~31) + perm32(R & 31));
        voffA[i] = (unsigned)(R * K + C) * 2u; voffB[i] = (unsigned)(Rb * K + C) * 2u; }
    const size_t kstep = (size_t)(BK * 2);
    const size_t hstep = (size_t)HALF * K * 2;
    const size_t tstep = 2 * hstep;
    const unsigned ldsw = (unsigned)wid * 1024u;
    const int aoff = lds_byte(wr * 64 + fr, fq * 8), boff = lds_byte(wc * 32 + fr, fq * 8);
#define PG8_SA(b, h) (((b) * 2 + (h)) * HTB)
#define PG8_SB(b, h) ((4 + (b) * 2 + (h)) * HTB)
#define PG8_STAGE(bufoff, gbase, voff) do { _Pragma("unroll") for (int _i = 0; _i < 2; ++_i) \
        __builtin_amdgcn_global_load_lds((const unsigned*)((const char*)(gbase) + (voff)[_i]), (LAS unsigned*)(lds + (bufoff) + ldsw + _i * 8192), 16, 0, 0); } while (0)
#define PG8_LDA(dst, b, h) do { _Pragma("unroll") for (int m = 0; m < 4; ++m) _Pragma("unroll") for (int k = 0; k < 2; ++k) dst[m][k] = *(const LAS bf16x8*)(lds + PG8_SA(b, h) + aoff + m * 2048 + k * 1024); } while (0)
#define PG8_LDB(dst, b, h) do { _Pragma("unroll") for (int n = 0; n < 2; ++n) _Pragma("unroll") for (int k = 0; k < 2; ++k) dst[n][k] = *(const LAS bf16x8*)(lds + PG8_SB(b, h) + boff + n * 2048 + k * 1024); } while (0)
#define PG8_MMA(ai, bj, At, Bt) do { __builtin_amdgcn_s_setprio(1); _Pragma("unroll") for (int m = 0; m < 4; ++m) _Pragma("unroll") for (int n = 0; n < 2; ++n) _Pragma("unroll") for (int k = 0; k < 2; ++k) \
        acc[ai][bj][m][n] = __builtin_amdgcn_mfma_f32_16x16x32_bf16(Bt[n][k], At[m][k], acc[ai][bj][m][n], 0, 0, 0); __builtin_amdgcn_s_setprio(0); } while (0)
#define PG8_WAIT_V(n) asm volatile("s_waitcnt vmcnt(" #n ")" ::: "memory")
#define PG8_WAIT_L(n) asm volatile("s_waitcnt lgkmcnt(" #n ")" ::: "memory")
#define PG8_BAR __builtin_amdgcn_s_barrier()
#define PG8_SCHED __builtin_amdgcn_sched_barrier(0)
    Unit cur, nxt; int ui = 0;
    if (!S.next(0, cur)) return;
    f32x4 acc[2][2][4][2];
#pragma unroll
    for (int a = 0; a < 2; ++a)
#pragma unroll
        for (int b = 0; b < 2; ++b)
#pragma unroll
            for (int m = 0; m < 4; ++m)
#pragma unroll
                for (int n = 0; n < 2; ++n) acc[a][b][m][n] = (f32x4){0.f, 0.f, 0.f, 0.f};
    bf16x8 At[4][2], B0[2][2], B1[2][2];
    const char* cA = (const char*)g.A + (size_t)cur.pm * tstep; const char* cB = (const char*)g.Bt + (size_t)cur.pn * tstep;
    PG8_STAGE(PG8_SB(0, 0), cB, voffB); PG8_STAGE(PG8_SB(0, 1), cB + hstep, voffB); PG8_STAGE(PG8_SA(0, 0), cA, voffA); PG8_STAGE(PG8_SA(0, 1), cA + hstep, voffA);
    if (wr == 1) PG8_BAR;
    PG8_WAIT_V(2); PG8_BAR;
    PG8_STAGE(PG8_SB(1, 0), cB + kstep, voffB); PG8_STAGE(PG8_SA(1, 0), cA + kstep, voffA); PG8_STAGE(PG8_SB(1, 1), cB + hstep + kstep, voffB);
    PG8_WAIT_V(6); PG8_BAR;
    for (;;) {
        const bool has_next = S.next(ui + 1, nxt);
        const char* nA = has_next ? (const char*)g.A + (size_t)nxt.pm * tstep : cA; const char* nB = has_next ? (const char*)g.Bt + (size_t)nxt.pn * tstep : cB;
        for (int t = 0; t < nt; t += 2) {
            const bool last = (t == nt - 2);
            const char* a1 = cA + (size_t)(t + 1) * kstep;
            const char* a2 = last ? nA : cA + (size_t)(t + 2) * kstep; const char* b2 = last ? nB : cB + (size_t)(t + 2) * kstep;
            const char* a3 = a2 + kstep; const char* b3 = b2 + kstep;
            PG8_LDB(B0, 0, 0); PG8_LDB(B1, 0, 1); PG8_SCHED; PG8_LDA(At, 0, 0); PG8_STAGE(PG8_SA(1, 1), a1 + hstep, voffA);
            PG8_WAIT_V(8); PG8_WAIT_L(0); PG8_BAR; PG8_MMA(0, 0, At, B0); PG8_MMA(0, 1, At, B1); PG8_BAR; PG8_SCHED;
            PG8_LDA(At, 0, 1); PG8_STAGE(PG8_SB(0, 0), b2, voffB); PG8_STAGE(PG8_SB(0, 1), b2 + hstep, voffB); PG8_STAGE(PG8_SA(0, 0), a2, voffA);
            PG8_WAIT_V(8); PG8_WAIT_L(0); PG8_BAR; PG8_MMA(1, 0, At, B0); PG8_MMA(1, 1, At, B1); PG8_BAR; PG8_SCHED;
            PG8_LDB(B0, 1, 0); PG8_LDB(B1, 1, 1); PG8_SCHED; PG8_LDA(At, 1, 0); PG8_STAGE(PG8_SA(0, 1), a2 + hstep, voffA);
            PG8_WAIT_V(8); PG8_WAIT_L(0); PG8_BAR; PG8_MMA(0, 0, At, B0); PG8_MMA(0, 1, At, B1); PG8_BAR; PG8_SCHED;
            PG8_LDA(At, 1, 1); PG8_STAGE(PG8_SB(1, 0), b3, voffB); PG8_STAGE(PG8_SB(1, 1), b3 + hstep, voffB); PG8_STAGE(PG8_SA(1, 0), a3, voffA);
            PG8_WAIT_V(8); PG8_WAIT_L(0); PG8_BAR; PG8_MMA(1, 0, At, B0); PG8_MMA(1, 1, At, B1); PG8_BAR; PG8_SCHED;
        }
        if (wr == 0) PG8_BAR;
        E(acc, cur, wr, wc, fr, fq);
        if (!has_next) break;
#pragma unroll
        for (int a = 0; a < 2; ++a)
#pragma unroll
            for (int b = 0; b < 2; ++b)
#pragma unroll
                for (int m = 0; m < 4; ++m)
#pragma unroll
                    for (int n = 0; n < 2; ++n) acc[a][b][m][n] = (f32x4){0.f, 0.f, 0.f, 0.f};
        cur = nxt; cA = nA; cB = nB; ++ui;
        if (wr == 1) PG8_BAR;
    }
    PG8_WAIT_V(0);
    PG8_BAR;
#undef PG8_SA
#undef PG8_SB
#undef PG8_STAGE
#undef PG8_LDA
#undef PG8_LDB
#undef PG8_MMA
#undef PG8_WAIT_V
#undef PG8_WAIT_L
#undef PG8_BAR
#undef PG8_SCHED
}
}

__device__ __forceinline__ u32x4 pack8(const f32x4 a, const f32x4 b) { u32x4 w; w.x = cvt_pk_bf16(a[0], a[1]); w.y = cvt_pk_bf16(a[2], a[3]); w.z = cvt_pk_bf16(b[0], b[1]); w.w = cvt_pk_bf16(b[2], b[3]); return w; }

struct EpiPlain {
    bf16_t* O; int ldc;
    __device__ __forceinline__ void operator()(const f32x4 (&acc)[2][2][4][2], const pg8::Unit& u, int wr, int wc, int fr, int fq) const {
        const int row0 = u.pm * 256 + wr * 64 + fr, col0 = u.pn * 256 + wc * 32 + 8 * fq;
#pragma unroll
        for (int ai = 0; ai < 2; ++ai)
#pragma unroll
            for (int m = 0; m < 4; ++m) { bf16_t* rowp = O + (size_t)(row0 + ai * 128 + m * 16) * ldc + col0;
#pragma unroll
                for (int bj = 0; bj < 2; ++bj) *(u32x4*)(rowp + bj * 128) = pack8(acc[ai][bj][m][0], acc[ai][bj][m][1]); }
    }
};
struct EpiGlu {
    bf16_t* O;
    __device__ __forceinline__ void operator()(const f32x4 (&acc)[2][2][4][2], const pg8::Unit& u, int wr, int wc, int fr, int fq) const {
        const int row0 = u.pm * 256 + wr * 64 + fr, col0 = u.pn * 128 + wc * 32 + 8 * fq;
#pragma unroll
        for (int ai = 0; ai < 2; ++ai)
#pragma unroll
            for (int m = 0; m < 4; ++m) { bf16_t* rowp = O + (size_t)(row0 + ai * 128 + m * 16) * FF + col0;
                f32x4 o0, o1;
#pragma unroll
                for (int j = 0; j < 4; ++j) { o0[j] = silu_f(acc[ai][0][m][0][j]) * acc[ai][1][m][0][j]; o1[j] = silu_f(acc[ai][0][m][1][j]) * acc[ai][1][m][1][j]; }
                *(u32x4*)rowp = pack8(o0, o1); }
    }
};
struct EpiProj {
    bf16_t *Q, *Kb, *V, *SG, *U; const f32x2* rope; float* out;
    __device__ __forceinline__ void operator()(const f32x4 (&acc)[2][2][4][2], const pg8::Unit& u, int wr, int wc, int fr, int fq) const {
        const int pn = u.pn, jj0 = wc * 32 + 8 * fq;
        if (pn < 4) {
            const int sec = pn >> 1, head = (pn & 1) * 2 + (wc >> 1), dlow = (wc & 1) * 32 + 8 * fq;
            const float lg2 = lg2gamma(head);
            bf16_t* dst = sec ? Kb : Q;
#pragma unroll
            for (int ai = 0; ai < 2; ++ai)
#pragma unroll
                for (int m = 0; m < 4; ++m) {
                    const int r = u.pm * 256 + ai * 128 + wr * 64 + m * 16 + fr;
                    int pidx, li;
                    if (r < ROW_S) { pidx = 16 + (r & 2047); li = r & 127; }
                    else if (r < ROW_M) { pidx = 2064; li = 0; }
                    else if (r < ROW_E) { pidx = r - ROW_M; li = 112 + pidx; }
                    else { pidx = 0; li = 0; }
                    const float sc = sec ? 0.08838834764831845f * exp2f(-lg2 * (float)li) : exp2f(lg2 * (float)li);
                    const f32x4* rp = (const f32x4*)(rope + (size_t)pidx * 64 + dlow);
                    const f32x4 cs0 = rp[0], cs1 = rp[1], cs2 = rp[2], cs3 = rp[3];
                    const f32x4 x1a = acc[ai][0][m][0], x1b = acc[ai][0][m][1], x2a = acc[ai][1][m][0], x2b = acc[ai][1][m][1];
                    f32x4 o1a, o1b, o2a, o2b;
                    o1a[0] = (x1a[0] * cs0[0] - x2a[0] * cs0[1]) * sc; o2a[0] = (x1a[0] * cs0[1] + x2a[0] * cs0[0]) * sc;
                    o1a[1] = (x1a[1] * cs0[2] - x2a[1] * cs0[3]) * sc; o2a[1] = (x1a[1] * cs0[3] + x2a[1] * cs0[2]) * sc;
                    o1a[2] = (x1a[2] * cs1[0] - x2a[2] * cs1[1]) * sc; o2a[2] = (x1a[2] * cs1[1] + x2a[2] * cs1[0]) * sc;
                    o1a[3] = (x1a[3] * cs1[2] - x2a[3] * cs1[3]) * sc; o2a[3] = (x1a[3] * cs1[3] + x2a[3] * cs1[2]) * sc;
                    o1b[0] = (x1b[0] * cs2[0] - x2b[0] * cs2[1]) * sc; o2b[0] = (x1b[0] * cs2[1] + x2b[0] * cs2[0]) * sc;
                    o1b[1] = (x1b[1] * cs2[2] - x2b[1] * cs2[3]) * sc; o2b[1] = (x1b[1] * cs2[3] + x2b[1] * cs2[2]) * sc;
                    o1b[2] = (x1b[2] * cs3[0] - x2b[2] * cs3[1]) * sc; o2b[2] = (x1b[2] * cs3[1] + x2b[2] * cs3[0]) * sc;
                    o1b[3] = (x1b[3] * cs3[2] - x2b[3] * cs3[3]) * sc; o2b[3] = (x1b[3] * cs3[3] + x2b[3] * cs3[2]) * sc;
                    bf16_t* rowp = dst + (size_t)r * 512 + head * 128 + dlow;
                    *(u32x4*)rowp = pack8(o1a, o1b);
                    *(u32x4*)(rowp + 64) = pack8(o2a, o2b);
                }
        } else if (pn < 8) {
            bf16_t* dst = pn < 6 ? V : SG; const bool act = pn >= 6;
            const int colt = (pn & 1) * 256 + jj0;
#pragma unroll
            for (int ai = 0; ai < 2; ++ai)
#pragma unroll
                for (int m = 0; m < 4; ++m) {
                    const int r = u.pm * 256 + ai * 128 + wr * 64 + m * 16 + fr;
#pragma unroll
                    for (int bj = 0; bj < 2; ++bj) {
                        f32x4 a = acc[ai][bj][m][0], b = acc[ai][bj][m][1];
                        if (act) {
#pragma unroll
                            for (int j = 0; j < 4; ++j) { a[j] = silu_f(a[j]); b[j] = silu_f(b[j]); } }
                        *(u32x4*)(dst + (size_t)r * 512 + colt + bj * 128) = pack8(a, b); }
                }
        } else {
            const int c0 = (pn - 8) * 128 + jj0;
#pragma unroll
            for (int ai = 0; ai < 2; ++ai)
#pragma unroll
                for (int m = 0; m < 4; ++m) {
                    const int r = u.pm * 256 + ai * 128 + wr * 64 + m * 16 + fr;
                    f32x4 o0, o1;
#pragma unroll
                    for (int j = 0; j < 4; ++j) { o0[j] = acc[ai][0][m][0][j] / (1.0f + __expf(-acc[ai][1][m][0][j])); o1[j] = acc[ai][0][m][1][j] / (1.0f + __expf(-acc[ai][1][m][1][j])); }
                    *(u32x4*)(U + (size_t)r * 512 + c0) = pack8(o0, o1);
                    if (r < ROW_S) { const int s = r & 2047; if (s >= SEQ - 30) { float* p = out + OFF_CONVP + ((size_t)((r >> 11) * 30 + (s - (SEQ - 30))) * 512 + c0); *(f32x4*)p = o0; *(f32x4*)(p + 4) = o1; } }
                    else if (r < ROW_M) { float* p = out + OFF_CONVS + ((size_t)((r - ROW_S) * 30 + 29) * 512 + c0); *(f32x4*)p = o0; *(f32x4*)(p + 4) = o1; }
                }
        }
    }
};

__device__ __forceinline__ int src_w1(int n) {
    const int pn = n >> 8, j = n & 255, bj = j >> 7, jj = j & 127;
    if (pn < 4) { const int sec = pn >> 1, head = (pn & 1) * 2 + (jj >> 6), d = (jj & 63) + 64 * bj; return sec * 512 + head * 128 + d; }
    if (pn < 8) return n;
    return 2048 + 512 * bj + 128 * (pn - 8) + jj;
}
__device__ __forceinline__ int src_w3(int n) { const int pn = n >> 8, j = n & 255, bj = j >> 7, jj = j & 127; return FF * bj + 128 * pn + jj; }
template <int MODE>
__device__ __forceinline__ void p0_transpose_item(const float* W, int K, int N, bf16_t* WT, LAS float* scr, int item, int lane) {
    const int nblk = N / 32, kb = item / nblk, nb = item % nblk, k0 = 64 * kb, n0 = 32 * nb;
    const int s0 = MODE == 1 ? src_w1(n0) : MODE == 2 ? src_w3(n0) : n0;
#pragma unroll 8
    for (int i = 0; i < 32; ++i) { const int kk = 2 * i + (lane >> 5); scr[kk * 33 + (lane & 31)] = W[(size_t)(k0 + kk) * N + s0 + (lane & 31)]; }
    asm volatile("s_waitcnt lgkmcnt(0)" ::: "memory");
    const int c = lane & 7;
#pragma unroll
    for (int j = 0; j < 4; ++j) { const int n = (lane >> 3) + 8 * j; const LAS float* s = scr + (8 * c) * 33 + n;
        u32x4 o; o.x = cvt_pk_bf16(s[0 * 33], s[1 * 33]); o.y = cvt_pk_bf16(s[2 * 33], s[3 * 33]); o.z = cvt_pk_bf16(s[4 * 33], s[5 * 33]); o.w = cvt_pk_bf16(s[6 * 33], s[7 * 33]);
        *(u32x4*)(WT + (size_t)(n0 + n) * K + k0 + 8 * c) = o; }
    asm volatile("s_waitcnt lgkmcnt(0)" ::: "memory");
}
__device__ __forceinline__ void sincos_acc(float angf, float& s, float& c) {
    const double a = (double)angf; const double n = rint(a * 0.15915494309189535);
    double r = fma(-n, 6.283185307179586, a); r = fma(-n, 2.4492935982947064e-16, r);
    const double h = 0.5 * r, h2 = h * h;
    double sp = -1.0 / 1307674368000.0; sp = sp * h2 + 1.0 / 6227020800.0; sp = sp * h2 - 1.0 / 39916800.0; sp = sp * h2 + 1.0 / 362880.0; sp = sp * h2 - 1.0 / 5040.0; sp = sp * h2 + 1.0 / 120.0; sp = sp * h2 - 1.0 / 6.0; sp = sp * h2 + 1.0;
    const double sh = sp * h;
    double cp = 1.0 / 20922789888000.0; cp = cp * h2 - 1.0 / 87178291200.0; cp = cp * h2 + 1.0 / 479001600.0; cp = cp * h2 - 1.0 / 3628800.0; cp = cp * h2 + 1.0 / 40320.0; cp = cp * h2 - 1.0 / 720.0; cp = cp * h2 + 1.0 / 24.0; cp = cp * h2 - 0.5; cp = cp * h2 + 1.0;
    s = (float)(2.0 * sh * cp); c = (float)(1.0 - 2.0 * sh * sh);
}
__device__ __forceinline__ void rms_row_to_bf16(const float* xrow, const float* w, bf16_t* orow, int lane) {
    const f32x4* xr = (const f32x4*)xrow + lane; const f32x4* wr4 = (const f32x4*)w + lane;
    f32x4 v[4]; float s = 0.f;
#pragma unroll
    for (int j = 0; j < 4; ++j) { v[j] = xr[64 * j]; s += (v[j].x * v[j].x + v[j].y * v[j].y) + (v[j].z * v[j].z + v[j].w * v[j].w); }
    const float rstd = 1.0f / sqrtf(wave_sum(s) * (1.f / D) + EPS);
    u32x2* o8 = (u32x2*)orow + lane;
#pragma unroll
    for (int j = 0; j < 4; ++j) { const f32x4 g = wr4[64 * j]; u32x2 o; o.x = cvt_pk_bf16(v[j].x * rstd * g.x, v[j].y * rstd * g.y); o.y = cvt_pk_bf16(v[j].z * rstd * g.z, v[j].w * rstd * g.w); o8[64 * j] = o; }
}

__device__ __forceinline__ unsigned off_b(unsigned row, unsigned ch) { return 256u * row + 16u * (ch ^ (((row & 3) << 2) | ((row >> 2) & 3))); }
__device__ __forceinline__ void load_tile128(LAS unsigned char* img, const bf16_t* g, size_t pitch, int tid, int zrows) {
#pragma unroll
    for (int i = 0; i < 4; ++i) { const int n = tid + 512 * i, row = n >> 4, ch = n & 15;
        u32x4 v = (u32x4){0u, 0u, 0u, 0u};
        if (row >= zrows) v = *(const u32x4*)(g + (size_t)(row - zrows) * pitch + ch * 8);
        *(LAS u32x4*)(img + off_b(row, ch)) = v; }
}
__device__ __forceinline__ bf16x8 tr_read2(unsigned a0, unsigned a1) {
    s16x4 r0, r1;
    asm volatile("ds_read_b64_tr_b16 %0, %2\n\tds_read_b64_tr_b16 %1, %3\n\ts_waitcnt lgkmcnt(0)" : "=&v"(r0), "=&v"(r1) : "v"(a0), "v"(a1) : "memory");
    bf16x8 o; o[0] = r0[0]; o[1] = r0[1]; o[2] = r0[2]; o[3] = r0[3]; o[4] = r1[0]; o[5] = r1[1]; o[6] = r1[2]; o[7] = r1[3]; return o;
}

__device__ __forceinline__ void kv_compute(LAS unsigned char* lds, float* dst, float scale, int w, int lane) {
    const unsigned bK = (unsigned)(uintptr_t)lds, bV = bK + 32768u;
    const unsigned g = lane >> 4, q = (lane & 15) >> 2, p = lane & 3;
    bf16x8 Kf[4];
#pragma unroll
    for (int ks = 0; ks < 4; ++ks) Kf[ks] = tr_read2(bK + off_b(32 * ks + 8 * g + q, 2 * w + (p >> 1)) + 8 * (p & 1), bK + off_b(32 * ks + 8 * g + 4 + q, 2 * w + (p >> 1)) + 8 * (p & 1));
#pragma unroll
    for (int et = 0; et < 8; ++et) {
        f32x4 acc = (f32x4){0.f, 0.f, 0.f, 0.f};
#pragma unroll
        for (int ks = 0; ks < 4; ++ks) {
            const bf16x8 Vf = tr_read2(bV + off_b(32 * ks + 8 * g + q, 2 * et + (p >> 1)) + 8 * (p & 1), bV + off_b(32 * ks + 8 * g + 4 + q, 2 * et + (p >> 1)) + 8 * (p & 1));
            acc = __builtin_amdgcn_mfma_f32_16x16x32_bf16(Vf, Kf[ks], acc, 0, 0, 0);
        }
        *(f32x4*)(dst + (size_t)(16 * w + (lane & 15)) * 128 + 16 * et + 4 * g) = acc * scale;
    }
}

__device__ __forceinline__ void ln8_stats(const float (&y)[8], float (&mu)[8], float (&rs)[8], LAS f32x2* red, int w, int lane) {
#pragma unroll
    for (int t = 0; t < 8; ++t) { const float s = wave_sum(y[t]), qq = wave_sum(y[t] * y[t]); if (lane == 0) red[w * 8 + t] = (f32x2){s, qq}; }
    __syncthreads();
#pragma unroll
    for (int t = 0; t < 8; ++t) { float s = 0.f, qq = 0.f;
#pragma unroll
        for (int ww = 0; ww < 8; ++ww) { const f32x2 v = red[ww * 8 + t]; s += v.x; qq += v.y; }
        const float m = s * (1.f / CC); float var = qq * (1.f / CC) - m * m; var = var < 0.f ? 0.f : var; mu[t] = m; rs[t] = 1.0f / sqrtf(var + EPS); }
    __syncthreads();
}


#define XB_TMO      128
#define XB_XCNT(j)  (256  + 64 * (j))
#define XB_XSUB(j)  (1280 + 64 * (j))
#define XB_XGEN(j)  (2304 + 64 * (j))
#define XB_TOP      3328
#define XB_TOPGEN   3392
#define XCD_BAR_WORDS 3456
#define XB_SPIN_CAP (1u << 22)
__device__ __forceinline__ unsigned xb_ld(unsigned* p)              { return __hip_atomic_load(p, __ATOMIC_RELAXED, __HIP_MEMORY_SCOPE_AGENT); }
__device__ __forceinline__ unsigned xb_add(unsigned* p, unsigned v) { return __hip_atomic_fetch_add(p, v, __ATOMIC_RELAXED, __HIP_MEMORY_SCOPE_AGENT); }
__device__ __forceinline__ unsigned xb_xcc_id() { return (unsigned)__builtin_amdgcn_s_getreg((3 << 11) | 20) & 0xFu; }
#define XB_SPIN(cond, bar) do { unsigned _sp = 0; while (cond) { __builtin_amdgcn_s_sleep(1); \
    if ((++_sp & 255u) == 0u) { if (xb_ld(&(bar)[XB_TMO])) break; if (_sp > XB_SPIN_CAP) { atomicAdd(&(bar)[XB_TMO], 1u); break; } } } } while (0)
struct XcdBarrier { unsigned* bar; unsigned x; volatile LAS unsigned* st; };
__device__ __forceinline__ XcdBarrier xcd_barrier_post(unsigned* bar, volatile LAS unsigned* st) {
    XcdBarrier b; b.bar = bar; b.x = xb_xcc_id(); b.st = st;
    if (threadIdx.x == 0) (void)xb_add(&bar[XB_XCNT(b.x)], 1u);
    return b;
}
__device__ __forceinline__ void xcd_barrier_complete(unsigned* bar, unsigned x, unsigned& nloc, unsigned& nx) {
    const unsigned G = gridDim.x * gridDim.y * gridDim.z;
    unsigned sum, cnt, mine, sp = 0u;
    for (;;) {
        sum = 0u; cnt = 0u; mine = 0u;
#pragma unroll
        for (unsigned j = 0; j < 16; ++j) { const unsigned c = xb_ld(&bar[XB_XCNT(j)]); sum += c; cnt += (c > 0u) ? 1u : 0u; mine = (j == x) ? c : mine; }
        if (sum == G) break;
        __builtin_amdgcn_s_sleep(1);
        if ((++sp & 255u) == 0u) { if (xb_ld(&bar[XB_TMO])) break; if (sp > XB_SPIN_CAP) { atomicAdd(&bar[XB_TMO], 1u); break; } }
    }
    nloc = mine > 0u ? mine : 1u; nx = cnt > 0u ? cnt : 1u;
}
__device__ __forceinline__ void xcd_barrier(const XcdBarrier& b) {
    asm volatile("s_waitcnt vmcnt(0)" ::: "memory");
    __syncthreads();
    if (threadIdx.x == 0) {
        unsigned* bar = b.bar;
        __builtin_amdgcn_s_waitcnt(0);
        unsigned nloc = b.st[0], nx = b.st[1];
        if (nloc == 0u) { xcd_barrier_complete(bar, b.x, nloc, nx); b.st[0] = nloc; b.st[1] = nx; }
        const unsigned old = xb_add(&bar[XB_XSUB(b.x)], 1u);
        const unsigned gen = old / nloc;
        if (old + 1u == (gen + 1u) * nloc) {
            __builtin_amdgcn_fence(__ATOMIC_RELEASE, "agent");
            asm volatile("s_waitcnt vmcnt(0)" ::: "memory");
            const unsigned og = xb_add(&bar[XB_TOP], 1u);
            const unsigned tg = og / nx;
            if (og + 1u == (tg + 1u) * nx) xb_add(&bar[XB_TOPGEN], 1u);
            else XB_SPIN(xb_ld(&bar[XB_TOPGEN]) == tg, bar);
            __builtin_amdgcn_fence(__ATOMIC_ACQUIRE, "agent");
            xb_add(&bar[XB_XGEN(b.x)], 1u);
            asm volatile("s_waitcnt vmcnt(0)" ::: "memory");
        } else {
            XB_SPIN(xb_ld(&bar[XB_XGEN(b.x)]) == gen, bar);
            __builtin_amdgcn_fence(__ATOMIC_ACQUIRE, "agent");
            asm volatile("s_waitcnt vmcnt(0)" ::: "memory");
        }
    }
    __syncthreads();
}
#ifndef REP_MASK
#define REP_MASK 0
#endif
#ifndef EXTRA_SYNCS
#define EXTRA_SYNCS 0
#endif
#define REP_BEGIN(k) { int nrep_ = 1 + ((REP_MASK >> (k)) & 1); asm volatile("" : "+s"(nrep_)); for (int rep_ = 0; rep_ < nrep_; ++rep_) { if (rep_) GRID_SYNC();
#define REP_END } }
struct Args { const float* in[17]; float* out; unsigned char* ws; };

__global__ void __launch_bounds__(512, 2) mk_fwd(Args a) {
    extern __shared__ __attribute__((aligned(16))) unsigned char lds_raw[];
    LAS unsigned char* lds = (LAS unsigned char*)lds_raw;
    cg::grid_group grid = cg::this_grid();
    if (a.ws == nullptr) grid.sync();
    volatile LAS unsigned* bst = (volatile LAS unsigned*)(lds + 131072 + 64);
    if (threadIdx.x < 2) bst[threadIdx.x] = 0u;
    __syncthreads();
    const XcdBarrier xbar = xcd_barrier_post((unsigned*)(a.ws + WS_CTL), bst);
#define GRID_SYNC() xcd_barrier(xbar)
#define PHASE_IDS int tid = threadIdx.x; asm volatile("" : "+v"(tid)); const int lane = tid & 63, w = __builtin_amdgcn_readfirstlane(tid >> 6); (void)lane; (void)w;
    const int G = gridDim.x, bx = blockIdx.x;
    unsigned char* ws = a.ws; float* out = a.out;
    const float* x_prompt = a.in[0]; const float* x_sample = a.in[1]; const float* state_ret = a.in[2]; const float* state_conv = a.in[3]; const float* meta = a.in[4];
    const float* g_mix_pre = a.in[5]; const float* g_mix_post = a.in[6]; const float* g_ffn_pre = a.in[7]; const float* g_ffn_post = a.in[8];
    const float* w_in = a.in[9]; const float* conv_w = a.in[10]; const float* conv_b = a.in[11]; const float* ln_g = a.in[12]; const float* ln_b = a.in[13];
    const float* w_out = a.in[14]; const float* w_ffn_in = a.in[15]; const float* w_ffn_out = a.in[16];
    f32x2* ROPE = (f32x2*)(ws + WS_ROPE);
    bf16_t* W1T = (bf16_t*)(ws + WS_W1T); bf16_t* WOT = (bf16_t*)(ws + WS_WOT); bf16_t* W3T = (bf16_t*)(ws + WS_W3T); bf16_t* W4T = (bf16_t*)(ws + WS_W4T);
    bf16_t* XN = (bf16_t*)(ws + WS_XN);
    bf16_t* Qb = (bf16_t*)(ws + WS_Q); bf16_t* Kb = (bf16_t*)(ws + WS_K); bf16_t* Vb = (bf16_t*)(ws + WS_V); bf16_t* SGb = (bf16_t*)(ws + WS_SG); bf16_t* Ub = (bf16_t*)(ws + WS_U);
    bf16_t* MIXIN = (bf16_t*)(ws + WS_MIXIN); float* KV = (float*)(ws + WS_KV); bf16_t* RP = (bf16_t*)(ws + WS_RP); bf16_t* MIX = (bf16_t*)(ws + WS_MIX);
    bf16_t* ACT = (bf16_t*)(ws + WS_ACT); bf16_t* FFN = (bf16_t*)(ws + WS_FFN);

    REP_BEGIN(0) {
        PHASE_IDS
        LAS float* scr = (LAS float*)(lds + w * 16384);
        const int gw = bx * 8 + w, NGW = G * 8;
        constexpr int I1 = (D / 64) * (INC / 32), IO = (D / 64) * (D / 32), I3 = (D / 64) * (2 * FF / 32), I4 = (FF / 64) * (D / 32);
        for (int it = gw; it < I1 + IO + I3 + I4; it += NGW) {
            int r = it;
            if (r < I1) { p0_transpose_item<1>(w_in, D, INC, W1T, scr, r, lane); continue; } r -= I1;
            if (r < IO) { p0_transpose_item<0>(w_out, D, D, WOT, scr, r, lane); continue; } r -= IO;
            if (r < I3) { p0_transpose_item<2>(w_ffn_in, D, 2 * FF, W3T, scr, r, lane); continue; } r -= I3;
            p0_transpose_item<0>(w_ffn_out, FF, D, W4T, scr, r, lane);
        }
        for (int m = gw; m < MP; m += NGW) {
            bf16_t* orow = XN + (size_t)m * D;
            if (m < ROW_S) rms_row_to_bf16(x_prompt + (size_t)m * D, g_mix_pre, orow, lane);
            else if (m < ROW_M) rms_row_to_bf16(x_sample + (size_t)(m - ROW_S) * D, g_mix_pre, orow, lane);
            else if (m < ROW_E) rms_row_to_bf16(meta + (size_t)(m - ROW_M) * D, g_mix_pre, orow, lane);
            else { u32x2* o8 = (u32x2*)orow + lane;
#pragma unroll
                for (int j = 0; j < 4; ++j) o8[64 * j] = (u32x2){0u, 0u}; }
        }
        for (int idx = bx * 512 + tid; idx < 2065 * 64; idx += G * 512) {
            const int pi = idx >> 6, j = idx & 63;
            const float posf = pi == 2064 ? 16384.f : (float)pi;
            const float lin = (float)j / 63.0f;
            const float pw = (float)exp2((double)lin * 13.287712379549449);
            const float inv = 1.0f / pw;
            float s, c; sincos_acc(posf * inv, s, c);
            ROPE[idx] = (f32x2){c, s};
        }
    } REP_END
    GRID_SYNC();

    for (int es_ = 0; es_ < EXTRA_SYNCS; ++es_) GRID_SYNC();
    REP_BEGIN(1) {
        pg8::Gemm g{XN, W1T, MP, INC, D}; pg8::StaticOrder S; S.init(MP, INC, G, bx);
        EpiProj E{Qb, Kb, Vb, SGb, Ub, ROPE, out};
        pg8::gemm_phase<EpiProj>(lds, g, S, E);
    } REP_END
    GRID_SYNC();

    REP_BEGIN(2) {
        PHASE_IDS
        constexpr int N_KV = 512, N_KVM = 4, N_SR = NS * NH, N_CP = ROW_S / 32, N_CS = NS / 8;
        constexpr int I_KVM = N_KV, I_SR = I_KVM + N_KVM, I_CP = I_SR + N_SR, I_CS = I_CP + N_CP, I_END = I_CS + N_CS;
        for (int it = bx; it < I_SR; it += G) {
            {
                const bool ismeta = it >= I_KVM;
                const int h = ismeta ? it - I_KVM : (it >> 4) & 3;
                const int row0 = ismeta ? ROW_M : (it >> 6) * SEQ + (it & 15) * 128;
                __syncthreads();
                load_tile128(lds, Kb + (size_t)row0 * 512 + h * 128, 512, tid, ismeta ? 112 : 0);
                load_tile128(lds + 32768, Vb + (size_t)row0 * 512 + h * 128, 512, tid, ismeta ? 112 : 0);
                __syncthreads();
                kv_compute(lds, KV + (size_t)it * 16384, exp2f(lg2gamma(h) * 127.f), w, lane);
            }
        }
        for (int it = I_SR + bx; it < I_CP; it += G) {
            {
                const int sr = it - I_SR, i = sr >> 2, h = sr & 3, r = ROW_S + i;
                const int e4 = tid & 31, dg = tid >> 5;
                const float gam = exp2f(lg2gamma(h));
                const float* S0 = state_ret + (size_t)sr * 16384; float* S1 = out + OFF_RETS + (size_t)sr * 16384;
                const u32x2 vv = *(const u32x2*)(Vb + (size_t)r * 512 + h * 128 + 4 * e4);
                const f32x4 v4 = (f32x4){bflo(vv.x), bfhi(vv.x), bflo(vv.y), bfhi(vv.y)};
                f32x4 oacc = (f32x4){0.f, 0.f, 0.f, 0.f};
#pragma unroll
                for (int ii = 0; ii < 8; ++ii) { const int d = dg + 16 * ii;
                    const float kd = bf2f(Kb[(size_t)r * 512 + h * 128 + d]), qd = bf2f(Qb[(size_t)r * 512 + h * 128 + d]);
                    f32x4 s = *(const f32x4*)(S0 + d * 128 + 4 * e4);
                    s = s * gam + v4 * kd;
                    *(f32x4*)(S1 + d * 128 + 4 * e4) = s;
                    oacc += s * qd; }
                LAS float* red = (LAS float*)lds;
                __syncthreads();
                *(LAS f32x4*)(red + dg * 128 + 4 * e4) = oacc;
                __syncthreads();
                if (tid < 128) { float o = 0.f;
#pragma unroll
                    for (int k = 0; k < 16; ++k) o += red[k * 128 + tid];
                    const float ss = wave_sum(o * o);
                    if (lane == 0) red[2048 + w] = ss;
                    red[2304 + tid] = o; }
                __syncthreads();
                if (tid < 128) { const float ss = red[2048] + red[2049]; const float o = red[2304 + tid] * (1.0f / sqrtf(ss * (1.f / HD) + EPS));
                    const float sg = bf2f(SGb[(size_t)r * 512 + h * 128 + tid]);
                    MIXIN[(size_t)r * 1024 + h * 128 + tid] = (bf16_t)(cvt_pk_bf16(o * sg, 0.f) & 0xffffu); }
            }
        }
        for (int it = I_CP + bx; it < I_CS; it += G) {
            {
                const int ct = it - I_CP, b = ct >> 6, s0 = (ct & 63) * 32;
                LAS bf16_t* ub = (LAS bf16_t*)lds;
                LAS f32x2* red = (LAS f32x2*)(lds + 65536);
                __syncthreads();
                for (int n = tid; n < 62 * 64; n += 512) { const int rho = n >> 6, ch = n & 63; const int P = 16 + s0 - 30 + rho;
                    u32x4 v = (u32x4){0u, 0u, 0u, 0u};
                    if (P >= 0) { const int row = P < 16 ? ROW_M + P : b * SEQ + P - 16; v = *(const u32x4*)(Ub + (size_t)row * 512 + ch * 8); }
                    *(LAS u32x4*)(ub + rho * 512 + ch * 8) = v; }
                float wj[31];
#pragma unroll
                for (int j = 0; j < 31; ++j) wj[j] = conv_w[j * 512 + tid];
                const float cb = conv_b[tid], lg = ln_g[tid], lb = ln_b[tid];
                __syncthreads();
                for (int grp = 0; grp < 4; ++grp) {
                    float win[38];
#pragma unroll
                    for (int k = 0; k < 38; ++k) win[k] = bf2f(ub[(grp * 8 + k) * 512 + tid]);
                    float y[8];
#pragma unroll
                    for (int t = 0; t < 8; ++t) { float acc = cb;
#pragma unroll
                        for (int j = 0; j < 31; ++j) acc += wj[j] * win[t + j];
                        y[t] = acc; }
                    float mu[8], rs[8]; ln8_stats(y, mu, rs, red, w, lane);
#pragma unroll
                    for (int t = 0; t < 8; ++t) { const float yn = (y[t] - mu[t]) * rs[t] * lg + lb; const int row = b * SEQ + s0 + grp * 8 + t;
                        MIXIN[(size_t)row * 1024 + 512 + tid] = (bf16_t)(cvt_pk_bf16(silu_f(yn), 0.f) & 0xffffu); }
                }
            }
        }
        for (int it = I_CS + bx; it < I_END; it += G) {
            {
                const int i0 = (it - I_CS) * 8;
                LAS f32x2* red = (LAS f32x2*)(lds + 65536);
                float wj[31];
#pragma unroll
                for (int j = 0; j < 31; ++j) wj[j] = conv_w[j * 512 + tid];
                const float cb = conv_b[tid], lg = ln_g[tid], lb = ln_b[tid];
                LAS float* ybuf = (LAS float*)lds;
                __syncthreads();
#pragma unroll 1
                for (int t = 0; t < 8; ++t) { const int i = i0 + t; float acc = cb;
                    const float* bufp = state_conv + (size_t)i * 30 * 512 + tid; float* op = out + OFF_CONVS + (size_t)i * 30 * 512 + tid;
#pragma unroll
                    for (int j = 0; j < 30; ++j) { const float bv = bufp[j * 512]; acc += wj[j] * bv; if (j >= 1) op[(j - 1) * 512] = bv; }
                    acc += wj[30] * bf2f(Ub[(size_t)(ROW_S + i) * 512 + tid]);
                    ybuf[t * 512 + tid] = acc; }
                float y[8];
#pragma unroll
                for (int t = 0; t < 8; ++t) y[t] = ybuf[t * 512 + tid];
                float mu[8], rs[8]; ln8_stats(y, mu, rs, red, w, lane);
#pragma unroll
                for (int t = 0; t < 8; ++t) { const float yn = (y[t] - mu[t]) * rs[t] * lg + lb;
                    MIXIN[(size_t)(ROW_S + i0 + t) * 1024 + 512 + tid] = (bf16_t)(cvt_pk_bf16(silu_f(yn), 0.f) & 0xffffu); }
            }
        }
    } REP_END
    GRID_SYNC();

    REP_BEGIN(3) {
        PHASE_IDS
        for (int idx = bx * 512 + tid; idx < 32 * 4096; idx += G * 512) {
            const int bh = idx >> 12, rem = idx & 4095, h = bh & 3;
            const float lg2 = lg2gamma(h), gam = exp2f(lg2), Gam = exp2f(lg2 * 128.f);
            f32x4 R = *(const f32x4*)(KV + (size_t)(512 + h) * 16384 + rem * 4);
            for (int c = 0; c < 16; ++c) {
                const f32x4 rs = R * gam; u32x2 o; o.x = cvt_pk_bf16(rs[0], rs[1]); o.y = cvt_pk_bf16(rs[2], rs[3]);
                *(u32x2*)(RP + (size_t)(bh * 16 + c) * 16384 + rem * 4) = o;
                R = R * Gam + *(const f32x4*)(KV + (size_t)(bh * 16 + c) * 16384 + rem * 4);
            }
            *(f32x4*)(out + OFF_RETP + (size_t)bh * 16384 + rem * 4) = R;
        }
    } REP_END
    GRID_SYNC();

    REP_BEGIN(4) {
        PHASE_IDS
        const unsigned bQ = (unsigned)(uintptr_t)lds, bKi = bQ + 32768u, bV = bQ + 65536u, bR = bQ + 98304u;
        const unsigned g = lane >> 4, q = (lane & 15) >> 2, p = lane & 3, fr = lane & 15;
        for (int it = bx; it < 512; it += G) {
            const int b = it >> 6, h = (it >> 4) & 3, c = it & 15;
            const int row0 = b * SEQ + c * 128;
            __syncthreads();
            load_tile128(lds, Qb + (size_t)row0 * 512 + h * 128, 512, tid, 0);
            load_tile128(lds + 32768, Kb + (size_t)row0 * 512 + h * 128, 512, tid, 0);
            load_tile128(lds + 65536, Vb + (size_t)row0 * 512 + h * 128, 512, tid, 0);
            load_tile128(lds + 98304, RP + (size_t)it * 16384, 128, tid, 0);
            __syncthreads();
            bf16x8 Qf[4];
#pragma unroll
            for (int s = 0; s < 4; ++s) Qf[s] = *(const LAS bf16x8*)(lds + off_b(fr + 16 * w, 4 * s + g));
            f32x4 accO[8];
#pragma unroll
            for (int et = 0; et < 8; ++et) {
                f32x4 acc = (f32x4){0.f, 0.f, 0.f, 0.f};
#pragma unroll
                for (int ks = 0; ks < 4; ++ks) {
                    const bf16x8 Rf = tr_read2(bR + off_b(32 * ks + 8 * g + q, 2 * et + (p >> 1)) + 8 * (p & 1), bR + off_b(32 * ks + 8 * g + 4 + q, 2 * et + (p >> 1)) + 8 * (p & 1));
                    acc = __builtin_amdgcn_mfma_f32_16x16x32_bf16(Rf, Qf[ks], acc, 0, 0, 0);
                }
                accO[et] = acc;
            }
            for (int jp = 0; 2 * jp <= w; ++jp) {
                const int ja = 2 * jp, jb = 2 * jp + 1;
                f32x4 sa = (f32x4){0.f, 0.f, 0.f, 0.f}, sb = (f32x4){0.f, 0.f, 0.f, 0.f};
#pragma unroll
                for (int s = 0; s < 4; ++s) { const bf16x8 Kf = *(const LAS bf16x8*)(lds + 32768 + off_b(fr + 16 * ja, 4 * s + g)); sa = __builtin_amdgcn_mfma_f32_16x16x32_bf16(Kf, Qf[s], sa, 0, 0, 0); }
                if (jb <= w) {
#pragma unroll
                    for (int s = 0; s < 4; ++s) { const bf16x8 Kf = *(const LAS bf16x8*)(lds + 32768 + off_b(fr + 16 * jb, 4 * s + g)); sb = __builtin_amdgcn_mfma_f32_16x16x32_bf16(Kf, Qf[s], sb, 0, 0, 0); }
                }
                if (ja == w) {
#pragma unroll
                    for (int rg = 0; rg < 4; ++rg) if (4 * g + rg > fr) sa[rg] = 0.f; }
                if (jb == w) {
#pragma unroll
                    for (int rg = 0; rg < 4; ++rg) if (4 * g + rg > fr) sb[rg] = 0.f; }
                bf16x8 Pf;
                { const unsigned p0 = cvt_pk_bf16(sa[0], sa[1]), p1 = cvt_pk_bf16(sa[2], sa[3]), p2 = cvt_pk_bf16(sb[0], sb[1]), p3 = cvt_pk_bf16(sb[2], sb[3]);
                  Pf[0] = (short)(p0 & 0xffff); Pf[1] = (short)(p0 >> 16); Pf[2] = (short)(p1 & 0xffff); Pf[3] = (short)(p1 >> 16);
                  Pf[4] = (short)(p2 & 0xffff); Pf[5] = (short)(p2 >> 16); Pf[6] = (short)(p3 & 0xffff); Pf[7] = (short)(p3 >> 16); }
#pragma unroll
                for (int et = 0; et < 8; ++et) {
                    const bf16x8 Vf = tr_read2(bV + off_b(32 * jp + 4 * g + q, 2 * et + (p >> 1)) + 8 * (p & 1), bV + off_b(32 * jp + 16 + 4 * g + q, 2 * et + (p >> 1)) + 8 * (p & 1));
                    accO[et] = __builtin_amdgcn_mfma_f32_16x16x32_bf16(Vf, Pf, accO[et], 0, 0, 0);
                }
            }
            float ss = 0.f;
#pragma unroll
            for (int et = 0; et < 8; ++et) ss += (accO[et][0] * accO[et][0] + accO[et][1] * accO[et][1]) + (accO[et][2] * accO[et][2] + accO[et][3] * accO[et][3]);
            ss += __shfl_xor(ss, 16); ss += __shfl_xor(ss, 32);
            const float rstd = 1.0f / sqrtf(ss * (1.f / HD) + EPS);
            const int row = row0 + 16 * w + fr;
#pragma unroll
            for (int et = 0; et < 8; ++et) {
                const u32x2 sg = *(const u32x2*)(SGb + (size_t)row * 512 + h * 128 + 16 * et + 4 * g);
                u32x2 o; o.x = cvt_pk_bf16(accO[et][0] * rstd * bflo(sg.x), accO[et][1] * rstd * bfhi(sg.x)); o.y = cvt_pk_bf16(accO[et][2] * rstd * bflo(sg.y), accO[et][3] * rstd * bfhi(sg.y));
                *(u32x2*)(MIXIN + (size_t)row * 1024 + h * 128 + 16 * et + 4 * g) = o;
            }
        }
        __syncthreads();
    } REP_END
    GRID_SYNC();

    REP_BEGIN(5) {
        pg8::Gemm g{MIXIN, WOT, MP, D, D}; pg8::StaticOrder S; S.init(MP, D, G, bx);
        EpiPlain E{MIX, D};
        pg8::gemm_phase<EpiPlain>(lds, g, S, E);
    } REP_END
    GRID_SYNC();

    REP_BEGIN(6) {
        PHASE_IDS
        const int gw = bx * 8 + w, NGW = G * 8;
        for (int m = gw; m < ROW_M; m += NGW) {
            const float* hrow = m < ROW_S ? x_prompt + (size_t)m * D : x_sample + (size_t)(m - ROW_S) * D;
            const f32x4* xr = (const f32x4*)hrow + lane; const u32x2* mr = (const u32x2*)(MIX + (size_t)m * D) + lane;
            f32x4 mv[4]; float s = 0.f;
#pragma unroll
            for (int j = 0; j < 4; ++j) { const u32x2 t = mr[64 * j]; mv[j] = (f32x4){bflo(t.x), bfhi(t.x), bflo(t.y), bfhi(t.y)}; s += (mv[j].x * mv[j].x + mv[j].y * mv[j].y) + (mv[j].z * mv[j].z + mv[j].w * mv[j].w); }
            const float rstd1 = 1.0f / sqrtf(wave_sum(s) * (1.f / D) + EPS);
            f32x4 hv[4]; float s2 = 0.f;
#pragma unroll
            for (int j = 0; j < 4; ++j) { const f32x4 gp = ((const f32x4*)g_mix_post + lane)[64 * j]; hv[j] = xr[64 * j] + mv[j] * rstd1 * gp;
                s2 += (hv[j].x * hv[j].x + hv[j].y * hv[j].y) + (hv[j].z * hv[j].z + hv[j].w * hv[j].w);
                ((f32x4*)(out + (size_t)m * D) + lane)[64 * j] = hv[j]; }
            const float rstd2 = 1.0f / sqrtf(wave_sum(s2) * (1.f / D) + EPS);
            u32x2* o8 = (u32x2*)(XN + (size_t)m * D) + lane;
#pragma unroll
            for (int j = 0; j < 4; ++j) { const f32x4 gp = ((const f32x4*)g_ffn_pre + lane)[64 * j]; u32x2 o; o.x = cvt_pk_bf16(hv[j].x * rstd2 * gp.x, hv[j].y * rstd2 * gp.y); o.y = cvt_pk_bf16(hv[j].z * rstd2 * gp.z, hv[j].w * rstd2 * gp.w); o8[64 * j] = o; }
        }
    } REP_END
    GRID_SYNC();

    REP_BEGIN(7) {
        pg8::Gemm g{XN, W3T, MP, 2 * FF, D}; pg8::StaticOrder S; S.init(MP, 2 * FF, G, bx);
        EpiGlu E{ACT};
        pg8::gemm_phase<EpiGlu>(lds, g, S, E);
    } REP_END
    GRID_SYNC();

    REP_BEGIN(8) {
        pg8::Gemm g{ACT, W4T, MP, D, FF}; pg8::StaticOrder S; S.init(MP, D, G, bx);
        EpiPlain E{FFN, D};
        pg8::gemm_phase<EpiPlain>(lds, g, S, E);
    } REP_END
    GRID_SYNC();

    REP_BEGIN(9) {
        PHASE_IDS
        const int gw = bx * 8 + w, NGW = G * 8;
        for (int m = gw; m < ROW_M; m += NGW) {
            const u32x2* fr2 = (const u32x2*)(FFN + (size_t)m * D) + lane;
            f32x4 fv[4]; float s = 0.f;
#pragma unroll
            for (int j = 0; j < 4; ++j) { const u32x2 t = fr2[64 * j]; fv[j] = (f32x4){bflo(t.x), bfhi(t.x), bflo(t.y), bfhi(t.y)}; s += (fv[j].x * fv[j].x + fv[j].y * fv[j].y) + (fv[j].z * fv[j].z + fv[j].w * fv[j].w); }
            const float rstd = 1.0f / sqrtf(wave_sum(s) * (1.f / D) + EPS);
            f32x4* orow = (f32x4*)(out + (size_t)m * D) + lane;
#pragma unroll
            for (int j = 0; j < 4; ++j) { const f32x4 gp = ((const f32x4*)g_ffn_post + lane)[64 * j]; orow[64 * j] = orow[64 * j] + fv[j] * rstd * gp; }
        }
    } REP_END
}

extern "C" void kernel_launch(void* const* d_in, const int* in_sizes, int n_in, void* d_out, int out_size, void* d_ws, size_t ws_size, hipStream_t stream) {
    static int grid = 0;
    if (grid == 0) {
        int dev = 0, cus = 0, per_cu = 0;
        hipGetDevice(&dev);
        hipDeviceGetAttribute(&cus, hipDeviceAttributeMultiprocessorCount, dev);
        hipFuncSetAttribute((const void*)mk_fwd, hipFuncAttributeMaxDynamicSharedMemorySize, LDS_BYTES);
        hipOccupancyMaxActiveBlocksPerMultiprocessor(&per_cu, (const void*)mk_fwd, 512, LDS_BYTES);
        if (per_cu < 1) per_cu = 1;
        grid = cus * per_cu;
        if (ws_size < WS_END || n_in != 17) { fprintf(stderr, "kernel_launch: unexpected ws %zu / n_in %d\n", ws_size, n_in); }
    }
    Args a{};
    for (int i = 0; i < 17; ++i) a.in[i] = (const float*)d_in[i];
    a.out = (float*)d_out; a.ws = (unsigned char*)d_ws;
    hipMemsetAsync((char*)d_ws + WS_CTL, 0, CTL_BYTES, stream);
    void* args[] = {&a};
    hipError_t e = hipLaunchCooperativeKernel((const void*)mk_fwd, dim3(grid), dim3(512), args, LDS_BYTES, stream);
    if (e != hipSuccess) fprintf(stderr, "cooperative launch failed: %s (grid %d)\n", hipGetErrorString(e), grid);
}
```

```cpp
#include <hip/hip_runtime.h>
#include <hip/hip_cooperative_groups.h>
#include <cstdio>
#include <cstdint>
namespace cg = cooperative_groups;

#define LAS __attribute__((address_space(3)))
typedef unsigned short bf16_t;
typedef short bf16x8 __attribute__((ext_vector_type(8)));
typedef short s16x4 __attribute__((ext_vector_type(4)));
typedef float f32x4 __attribute__((ext_vector_type(4)));
typedef float f32x2 __attribute__((ext_vector_type(2)));
typedef unsigned u32x4 __attribute__((ext_vector_type(4)));
typedef unsigned u32x2 __attribute__((ext_vector_type(2)));

constexpr int D = 1024, NB = 8, SEQ = 2048, NS = 128, NMETA = 16, NH = 4, HD = 128, RW = 512, CC = 512, CW = 31, FF = 2816, INC = 3072;
constexpr int ROW_S = NB * SEQ;
constexpr int ROW_M = ROW_S + NS;
constexpr int ROW_E = ROW_M + NMETA;
constexpr int MP = 16640;
constexpr float EPS = 1e-6f;
constexpr size_t OFF_YS = (size_t)ROW_S * D, OFF_RETP = OFF_YS + (size_t)NS * D, OFF_CONVP = OFF_RETP + (size_t)NB * NH * HD * HD,
                 OFF_RETS = OFF_CONVP + (size_t)NB * 30 * CC, OFF_CONVS = OFF_RETS + (size_t)NS * NH * HD * HD;
constexpr size_t KiB = 1024, MiB = 1u << 20;
constexpr size_t WS_ROPE = 0;
constexpr size_t WS_CTL = MiB + 512 * KiB, CTL_BYTES = 16384;
constexpr size_t WS_W1T = 2 * MiB, WS_WOT = 8 * MiB, WS_W3T = 10 * MiB, WS_W4T = 21 * MiB;
constexpr size_t WS_XN = 26 * MiB + 512 * KiB;
constexpr size_t SZ_QS = (size_t)MP * 512 * 2;
constexpr size_t WS_Q = 59 * MiB, WS_K = WS_Q + SZ_QS, WS_V = WS_K + SZ_QS, WS_SG = WS_V + SZ_QS, WS_U = WS_SG + SZ_QS;
constexpr size_t WS_MIXIN = WS_U + SZ_QS;
constexpr size_t WS_KV = WS_MIXIN + (size_t)MP * 1024 * 2;
constexpr size_t WS_RP = WS_KV + (size_t)516 * 65536;
constexpr size_t WS_MIX = WS_RP + (size_t)512 * 32768;
constexpr size_t WS_ACT = WS_Q;
constexpr size_t WS_FFN = WS_KV;
constexpr size_t WS_END = WS_MIX + (size_t)MP * 1024 * 2;
static_assert(WS_END <= 256 * MiB, "ws");
static_assert(WS_ACT + (size_t)MP * FF * 2 <= WS_KV, "act overlay");
static_assert(WS_FFN + (size_t)MP * 1024 * 2 <= WS_MIX, "ffn overlay");
constexpr int LDS_BYTES = 147456;

__device__ __forceinline__ unsigned cvt_pk_bf16(float lo, float hi) { unsigned r; asm volatile("v_cvt_pk_bf16_f32 %0, %1, %2" : "=v"(r) : "v"(lo), "v"(hi)); return r; }
__device__ __forceinline__ float bf2f(unsigned short b) { return __uint_as_float(((unsigned)b) << 16); }
__device__ __forceinline__ float bflo(unsigned w) { return __uint_as_float(w << 16); }
__device__ __forceinline__ float bfhi(unsigned w) { return __uint_as_float(w & 0xffff0000u); }
__device__ __forceinline__ float wave_sum(float v) {
#pragma unroll
    for (int o = 1; o < 64; o <<= 1) v += __shfl_xor(v, o);
    return v;
}
__device__ __forceinline__ float silu_f(float x) { return x / (1.0f + __expf(-x)); }
__device__ __forceinline__ float lg2gamma(int h) { return log2f(1.0f - exp2f(-5.0f - (float)h)); }

namespace pg8 {
constexpr int BM = 256, BK = 64, HALF = 128, HTB = HALF * BK * 2, STAGE_BYTES = 8 * HTB, NXCD = 8, WGM = 8;
__device__ __forceinline__ int lds_byte(int r, int c) { const int st = (r >> 4) * 2 + (c >> 5), rr = r & 15, cc = c & 31, ob = rr * 64 + cc * 2; return st * 1024 + (ob ^ (((ob >> 9) & 1) << 5)); }
__device__ __forceinline__ void stage_rc(int b, int& R, int& C) { const int st = b / 1024, sb = b % 1024, swz = sb ^ (((sb >> 9) & 1) << 5); R = (st >> 1) * 16 + swz / 64; C = (st & 1) * 32 + (swz % 64) / 2; }
__device__ __forceinline__ int perm32(int rho) { const int n = rho >> 4, i = rho & 15; return 8 * (i >> 2) + 4 * n + (i & 3); }
struct Unit { int pm, pn; };
struct Gemm { const bf16_t* A; const bf16_t* Bt; int M, N, K; };
struct StaticOrder {
    int nM, nN, nwg, G, c;
    __device__ void init(int M, int N, int G_, int c_) { nM = M / BM; nN = N / BM; nwg = nM * nN; G = G_; c = c_; }
    __device__ bool next(int i, Unit& u) const {
        const long L = (long)i * G + c; if (L >= nwg) return false;
        int wgid = (int)L; { const int q = nwg / NXCD, r = nwg % NXCD, xcd = wgid % NXCD, off = wgid / NXCD; wgid = (xcd < r ? xcd * (q + 1) : r * (q + 1) + (xcd - r) * q) + off; }
        const int nig = WGM * nN, gid = wgid / nig, fm = gid * WGM, gsz = (nM - fm) < WGM ? (nM - fm) : WGM;
        u.pm = fm + ((wgid % nig) % gsz); u.pn = (wgid % nig) / gsz; return true;
    }
};

template <class Epi>
__device__ __forceinline__ void gemm_phase(LAS unsigned char* lds, const Gemm g, const StaticOrder& S, const Epi& E) {
    int tid_ = threadIdx.x; asm volatile("" : "+v"(tid_));
    const int tid = tid_, wid = __builtin_amdgcn_readfirstlane(tid >> 6), lane = tid & 63, wr = wid >> 2, wc = wid & 3, fr = lane & 15, fq = lane >> 4;
    const int K = g.K, nt = K / BK;
    unsigned voffA[2], voffB[2];
#pragma unroll
    for (int i = 0; i < 2; ++i) { int R, C; stage_rc(tid * 16 + i * 8192, R, C); const int Rb = ((R & ~31) + perm32(R & 31));
        voffA[i] = (unsigned)(R * K + C) * 2u; voffB[i] = (unsigned)(Rb * K + C) * 2u; }
    const size_t kstep = (size_t)(BK * 2);
    const size_t hstep = (size_t)HALF * K * 2;
    const size_t tstep = 2 * hstep;
    const unsigned ldsw = (unsigned)wid * 1024u;
    const int aoff = lds_byte(wr * 64 + fr, fq * 8), boff = lds_byte(wc * 32 + fr, fq * 8);
#define PG8_SA(b, h) (((b) * 2 + (h)) * HTB)
#define PG8_SB(b, h) ((4 + (b) * 2 + (h)) * HTB)
#define PG8_STAGE(bufoff, gbase, voff) do { _Pragma("unroll") for (int _i = 0; _i < 2; ++_i) \
        __builtin_amdgcn_global_load_lds((const unsigned*)((const char*)(gbase) + (voff)[_i]), (LAS unsigned*)(lds + (bufoff) + ldsw + _i * 8192), 16, 0, 0); } while (0)
#define PG8_LDA(dst, b, h) do { _Pragma("unroll") for (int m = 0; m < 4; ++m) _Pragma("unroll") for (int k = 0; k < 2; ++k) dst[m][k] = *(const LAS bf16x8*)(lds + PG8_SA(b, h) + aoff + m * 2048 + k * 1024); } while (0)
#define PG8_LDB(dst, b, h) do { _Pragma("unroll") for (int n = 0; n < 2; ++n) _Pragma("unroll") for (int k = 0; k < 2; ++k) dst[n][k] = *(const LAS bf16x8*)(lds + PG8_SB(b, h) + boff + n * 2048 + k * 1024); } while (0)
#define PG8_MMA(ai, bj, At, Bt) do { __builtin_amdgcn_s_setprio(1); _Pragma("unroll") for (int m = 0; m < 4; ++m) _Pragma("unroll") for (int n = 0; n < 2; ++n) _Pragma("unroll") for (int k = 0; k < 2; ++k) \
        acc[ai][bj][m][n] = __builtin_amdgcn_mfma_f32_16x16x32_bf16(Bt[n][k], At[m][k], acc[ai][bj][m][n], 0, 0, 0); __builtin_amdgcn_s_setprio(0); } while (0)
#define PG8_WAIT_V(n) asm volatile("s_waitcnt vmcnt(" #n ")" ::: "memory")
#define PG8_WAIT_L(n) asm volatile("s_waitcnt lgkmcnt(" #n ")" ::: "memory")
#define PG8_BAR __builtin_amdgcn_s_barrier()
#define PG8_SCHED __builtin_amdgcn_sched_barrier(0)
    Unit cur, nxt; int ui = 0;
    if (!S.next(0, cur)) return;
    f32x4 acc[2][2][4][2];
#pragma unroll
    for (int a = 0; a < 2; ++a)
#pragma unroll
        for (int b = 0; b < 2; ++b)
#pragma unroll
            for (int m = 0; m < 4; ++m)
#pragma unroll
                for (int n = 0; n < 2; ++n) acc[a][b][m][n] = (f32x4){0.f, 0.f, 0.f, 0.f};
    bf16x8 At[4][2], B0[2][2], B1[2][2];
    const char* cA = (const char*)g.A + (size_t)cur.pm * tstep; const char* cB = (const char*)g.Bt + (size_t)cur.pn * tstep;
    PG8_STAGE(PG8_SB(0, 0), cB, voffB); PG8_STAGE(PG8_SB(0, 1), cB + hstep, voffB); PG8_STAGE(PG8_SA(0, 0), cA, voffA); PG8_STAGE(PG8_SA(0, 1), cA + hstep, voffA);
    if (wr == 1) PG8_BAR;
    PG8_WAIT_V(2); PG8_BAR;
    PG8_STAGE(PG8_SB(1, 0), cB + kstep, voffB); PG8_STAGE(PG8_SA(1, 0), cA + kstep, voffA); PG8_STAGE(PG8_SB(1, 1), cB + hstep + kstep, voffB);
    PG8_WAIT_V(6); PG8_BAR;
    for (;;) {
        const bool has_next = S.next(ui + 1, nxt);
        const char* nA = has_next ? (const char*)g.A + (size_t)nxt.pm * tstep : cA; const char* nB = has_next ? (const char*)g.Bt + (size_t)nxt.pn * tstep : cB;
        for (int t = 0; t < nt; t += 2) {
            const bool last = (t == nt - 2);
            const char* a1 = cA + (size_t)(t + 1) * kstep;
            const char* a2 = last ? nA : cA + (size_t)(t + 2) * kstep; const char* b2 = last ? nB : cB + (size_t)(t + 2) * kstep;
            const char* a3 = a2 + kstep; const char* b3 = b2 + kstep;
            PG8_LDB(B0, 0, 0); PG8_LDB(B1, 0, 1); PG8_SCHED; PG8_LDA(At, 0, 0); PG8_STAGE(PG8_SA(1, 1), a1 + hstep, voffA);
            PG8_WAIT_V(8); PG8_WAIT_L(0); PG8_BAR; PG8_MMA(0, 0, At, B0); PG8_MMA(0, 1, At, B1); PG8_BAR; PG8_SCHED;
            PG8_LDA(At, 0, 1); PG8_STAGE(PG8_SB(0, 0), b2, voffB); PG8_STAGE(PG8_SB(0, 1), b2 + hstep, voffB); PG8_STAGE(PG8_SA(0, 0), a2, voffA);
            PG8_WAIT_V(8); PG8_WAIT_L(0); PG8_BAR; PG8_MMA(1, 0, At, B0); PG8_MMA(1, 1, At, B1); PG8_BAR; PG8_SCHED;
            PG8_LDB(B0, 1, 0); PG8_LDB(B1, 1, 1); PG8_SCHED; PG8_LDA(At, 1, 0); PG8_STAGE(PG8_SA(0, 1), a2 + hstep, voffA);
            PG8_WAIT_V(8); PG8_WAIT_L(0); PG8_BAR; PG8_MMA(0, 0, At, B0); PG8_MMA(0, 1, At, B1); PG8_BAR; PG8_SCHED;
            PG8_LDA(At, 1, 1); PG8_STAGE(PG8_SB(1, 0), b3, voffB); PG8_STAGE(PG8_SB(1, 1), b3 + hstep, voffB); PG8_STAGE(PG8_SA(1, 0), a3, voffA);
            PG8_WAIT_V(8); PG8_WAIT_L(0); PG8_BAR; PG8_MMA(1, 0, At, B0); PG8_MMA(1, 1, At, B1); PG8_BAR; PG8_SCHED;
        }
        if (wr == 0) PG8_BAR;
        E(acc, cur, wr, wc, fr, fq);
        if (!has_next) break;
#pragma unroll
        for (int a = 0; a < 2; ++a)
#pragma unroll
            for (int b = 0; b < 2; ++b)
#pragma unroll
                for (int m = 0; m < 4; ++m)
#pragma unroll
                    for (int n = 0; n < 2; ++n) acc[a][b][m][n] = (f32x4){0.f, 0.f, 0.f, 0.f};
        cur = nxt; cA = nA; cB = nB; ++ui;
        if (wr == 1) PG8_BAR;
    }
    PG8_WAIT_V(0);
    PG8_BAR;
#undef PG8_SA
#undef PG8_SB
#undef PG8_STAGE
#undef PG8_LDA
#undef PG8_LDB
#undef PG8_MMA
#undef PG8_WAIT_V
#undef PG8_WAIT_L
#undef PG8_BAR
#undef PG8_SCHED
}
}

__device__ __forceinline__ u32x4 pack8(const f32x4 a, const f32x4 b) { u32x4 w; w.x = cvt_pk_bf16(a[0], a[1]); w.y = cvt_pk_bf16(a[2], a[3]); w.z = cvt_pk_bf16(b[0], b[1]); w.w = cvt_pk_bf16(b[2], b[3]); return w; }

struct EpiPlain {
    bf16_t* O; int ldc;
    __device__ __forceinline__ void operator()(const f32x4 (&acc)[2][2][4][2], const pg8::Unit& u, int wr, int wc, int fr, int fq) const {
        const int row0 = u.pm * 256 + wr * 64 + fr, col0 = u.pn * 256 + wc * 32 + 8 * fq;
#pragma unroll
        for (int ai = 0; ai < 2; ++ai)
#pragma unroll
            for (int m = 0; m < 4; ++m) { bf16_t* rowp = O + (size_t)(row0 + ai * 128 + m * 16) * ldc + col0;
#pragma unroll
                for (int bj = 0; bj < 2; ++bj) *(u32x4*)(rowp + bj * 128) = pack8(acc[ai][bj][m][0], acc[ai][bj][m][1]); }
    }
};
struct EpiGlu {
    bf16_t* O;
    __device__ __forceinline__ void operator()(const f32x4 (&acc)[2][2][4][2], const pg8::Unit& u, int wr, int wc, int fr, int fq) const {
        const int row0 = u.pm * 256 + wr * 64 + fr, col0 = u.pn * 128 + wc * 32 + 8 * fq;
#pragma unroll
        for (int ai = 0; ai < 2; ++ai)
#pragma unroll
            for (int m = 0; m < 4; ++m) { bf16_t* rowp = O + (size_t)(row0 + ai * 128 + m * 16) * FF + col0;
                f32x4 o0, o1;
#pragma unroll
                for (int j = 0; j < 4; ++j) { o0[j] = silu_f(acc[ai][0][m][0][j]) * acc[ai][1][m][0][j]; o1[j] = silu_f(acc[ai][0][m][1][j]) * acc[ai][1][m][1][j]; }
                *(u32x4*)rowp = pack8(o0, o1); }
    }
};
struct EpiProj {
    bf16_t *Q, *Kb, *V, *SG, *U; const f32x2* rope; float* out;
    __device__ __forceinline__ void operator()(const f32x4 (&acc)[2][2][4][2], const pg8::Unit& u, int wr, int wc, int fr, int fq) const {
        const int pn = u.pn, jj0 = wc * 32 + 8 * fq;
        if (pn < 4) {
            const int sec = pn >> 1, head = (pn & 1) * 2 + (wc >> 1), dlow = (wc & 1) * 32 + 8 * fq;
            const float lg2 = lg2gamma(head);
            bf16_t* dst = sec ? Kb : Q;
#pragma unroll
            for (int ai = 0; ai < 2; ++ai)
#pragma unroll
                for (int m = 0; m < 4; ++m) {
                    const int r = u.pm * 256 + ai * 128 + wr * 64 + m * 16 + fr;
                    int pidx, li;
                    if (r < ROW_S) { pidx = 16 + (r & 2047); li = r & 127; }
                    else if (r < ROW_M) { pidx = 2064; li = 0; }
                    else if (r < ROW_E) { pidx = r - ROW_M; li = 112 + pidx; }
                    else { pidx = 0; li = 0; }
                    const float sc = sec ? 0.08838834764831845f * exp2f(-lg2 * (float)li) : exp2f(lg2 * (float)li);
                    const f32x4* rp = (const f32x4*)(rope + (size_t)pidx * 64 + dlow);
                    const f32x4 cs0 = rp[0], cs1 = rp[1], cs2 = rp[2], cs3 = rp[3];
                    const f32x4 x1a = acc[ai][0][m][0], x1b = acc[ai][0][m][1], x2a = acc[ai][1][m][0], x2b = acc[ai][1][m][1];
                    f32x4 o1a, o1b, o2a, o2b;
                    o1a[0] = (x1a[0] * cs0[0] - x2a[0] * cs0[1]) * sc; o2a[0] = (x1a[0] * cs0[1] + x2a[0] * cs0[0]) * sc;
                    o1a[1] = (x1a[1] * cs0[2] - x2a[1] * cs0[3]) * sc; o2a[1] = (x1a[1] * cs0[3] + x2a[1] * cs0[2]) * sc;
                    o1a[2] = (x1a[2] * cs1[0] - x2a[2] * cs1[1]) * sc; o2a[2] = (x1a[2] * cs1[1] + x2a[2] * cs1[0]) * sc;
                    o1a[3] = (x1a[3] * cs1[2] - x2a[3] * cs1[3]) * sc; o2a[3] = (x1a[3] * cs1[3] + x2a[3] * cs1[2]) * sc;
                    o1b[0] = (x1b[0] * cs2[0] - x2b[0] * cs2[1]) * sc; o2b[0] = (x1b[0] * cs2[1] + x2b[0] * cs2[0]) * sc;
                    o1b[1] = (x1b[1] * cs2[2] - x2b[1] * cs2[3]) * sc; o2b[1] = (x1b[1] * cs2[3] + x2b[1] * cs2[2]) * sc;
                    o1b[2] = (x1b[2] * cs3[0] - x2b[2] * cs3[1]) * sc; o2b[2] = (x1b[2] * cs3[1] + x2b[2] * cs3[0]) * sc;
                    o1b[3] = (x1b[3] * cs3[2] - x2b[3] * cs3[3]) * sc; o2b[3] = (x1b[3] * cs3[3] + x2b[3] * cs3[2]) * sc;
                    bf16_t* rowp = dst + (size_t)r * 512 + head * 128 + dlow;
                    *(u32x4*)rowp = pack8(o1a, o1b);
                    *(u32x4*)(rowp + 64) = pack8(o2a, o2b);
                }
        } else if (pn < 8) {
            bf16_t* dst = pn < 6 ? V : SG; const bool act = pn >= 6;
            const int colt = (pn & 1) * 256 + jj0;
#pragma unroll
            for (int ai = 0; ai < 2; ++ai)
#pragma unroll
                for (int m = 0; m < 4; ++m) {
                    const int r = u.pm * 256 + ai * 128 + wr * 64 + m * 16 + fr;
#pragma unroll
                    for (int bj = 0; bj < 2; ++bj) {
                        f32x4 a = acc[ai][bj][m][0], b = acc[ai][bj][m][1];
                        if (act) {
#pragma unroll
                            for (int j = 0; j < 4; ++j) { a[j] = silu_f(a[j]); b[j] = silu_f(b[j]); } }
                        *(u32x4*)(dst + (size_t)r * 512 + colt + bj * 128) = pack8(a, b); }
                }
        } else {
            const int c0 = (pn - 8) * 128 + jj0;
#pragma unroll
            for (int ai = 0; ai < 2; ++ai)
#pragma unroll
                for (int m = 0; m < 4; ++m) {
                    const int r = u.pm * 256 + ai * 128 + wr * 64 + m * 16 + fr;
                    f32x4 o0, o1;
#pragma unroll
                    for (int j = 0; j < 4; ++j) { o0[j] = acc[ai][0][m][0][j] / (1.0f + __expf(-acc[ai][1][m][0][j])); o1[j] = acc[ai][0][m][1][j] / (1.0f + __expf(-acc[ai][1][m][1][j])); }
                    *(u32x4*)(U + (size_t)r * 512 + c0) = pack8(o0, o1);
                    if (r < ROW_S) { const int s = r & 2047; if (s >= SEQ - 30) { float* p = out + OFF_CONVP + ((size_t)((r >> 11) * 30 + (s - (SEQ - 30))) * 512 + c0); *(f32x4*)p = o0; *(f32x4*)(p + 4) = o1; } }
                    else if (r < ROW_M) { float* p = out + OFF_CONVS + ((size_t)((r - ROW_S) * 30 + 29) * 512 + c0); *(f32x4*)p = o0; *(f32x4*)(p + 4) = o1; }
                }
        }
    }
};

__device__ __forceinline__ int src_w1(int n) {
    const int pn = n >> 8, j = n & 255, bj = j >> 7, jj = j & 127;
    if (pn < 4) { const int sec = pn >> 1, head = (pn & 1) * 2 + (jj >> 6), d = (jj & 63) + 64 * bj; return sec * 512 + head * 128 + d; }
    if (pn < 8) return n;
    return 2048 + 512 * bj + 128 * (pn - 8) + jj;
}
__device__ __forceinline__ int src_w3(int n) { const int pn = n >> 8, j = n & 255, bj = j >> 7, jj = j & 127; return FF * bj + 128 * pn + jj; }
template <int MODE>
__device__ __forceinline__ void p0_transpose_item(const float* W, int K, int N, bf16_t* WT, LAS float* scr, int item, int lane) {
    const int nblk = N / 32, kb = item / nblk, nb = item % nblk, k0 = 64 * kb, n0 = 32 * nb;
    const int s0 = MODE == 1 ? src_w1(n0) : MODE == 2 ? src_w3(n0) : n0;
#pragma unroll 8
    for (int i = 0; i < 32; ++i) { const int kk = 2 * i + (lane >> 5); scr[kk * 33 + (lane & 31)] = W[(size_t)(k0 + kk) * N + s0 + (lane & 31)]; }
    asm volatile("s_waitcnt lgkmcnt(0)" ::: "memory");
    const int c = lane & 7;
#pragma unroll
    for (int j = 0; j < 4; ++j) { const int n = (lane >> 3) + 8 * j; const LAS float* s = scr + (8 * c) * 33 + n;
        u32x4 o; o.x = cvt_pk_bf16(s[0 * 33], s[1 * 33]); o.y = cvt_pk_bf16(s[2 * 33], s[3 * 33]); o.z = cvt_pk_bf16(s[4 * 33], s[5 * 33]); o.w = cvt_pk_bf16(s[6 * 33], s[7 * 33]);
        *(u32x4*)(WT + (size_t)(n0 + n) * K + k0 + 8 * c) = o; }
    asm volatile("s_waitcnt lgkmcnt(0)" ::: "memory");
}
__device__ __forceinline__ void sincos_acc(float angf, float& s, float& c) {
    const double a = (double)angf; const double n = rint(a * 0.15915494309189535);
    double r = fma(-n, 6.283185307179586, a); r = fma(-n, 2.4492935982947064e-16, r);
    const double h = 0.5 * r, h2 = h * h;
    double sp = -1.0 / 1307674368000.0; sp = sp * h2 + 1.0 / 6227020800.0; sp = sp * h2 - 1.0 / 39916800.0; sp = sp * h2 + 1.0 / 362880.0; sp = sp * h2 - 1.0 / 5040.0; sp = sp * h2 + 1.0 / 120.0; sp = sp * h2 - 1.0 / 6.0; sp = sp * h2 + 1.0;
    const double sh = sp * h;
    double cp = 1.0 / 20922789888000.0; cp = cp * h2 - 1.0 / 87178291200.0; cp = cp * h2 + 1.0 / 479001600.0; cp = cp * h2 - 1.0 / 3628800.0; cp = cp * h2 + 1.0 / 40320.0; cp = cp * h2 - 1.0 / 720.0; cp = cp * h2 + 1.0 / 24.0; cp = cp * h2 - 0.5; cp = cp * h2 + 1.0;
    s = (float)(2.0 * sh * cp); c = (float)(1.0 - 2.0 * sh * sh);
}
__device__ __forceinline__ void rms_row_to_bf16(const float* xrow, const float* w, bf16_t* orow, int lane) {
    const f32x4* xr = (const f32x4*)xrow + lane; const f32x4* wr4 = (const f32x4*)w + lane;
    f32x4 v[4]; float s = 0.f;
#pragma unroll
    for (int j = 0; j < 4; ++j) { v[j] = xr[64 * j]; s += (v[j].x * v[j].x + v[j].y * v[j].y) + (v[j].z * v[j].z + v[j].w * v[j].w); }
    const float rstd = 1.0f / sqrtf(wave_sum(s) * (1.f / D) + EPS);
    u32x2* o8 = (u32x2*)orow + lane;
#pragma unroll
    for (int j = 0; j < 4; ++j) { const f32x4 g = wr4[64 * j]; u32x2 o; o.x = cvt_pk_bf16(v[j].x * rstd * g.x, v[j].y * rstd * g.y); o.y = cvt_pk_bf16(v[j].z * rstd * g.z, v[j].w * rstd * g.w); o8[64 * j] = o; }
}

__device__ __forceinline__ unsigned off_b(unsigned row, unsigned ch) { return 256u * row + 16u * (ch ^ (((row & 3) << 2) | ((row >> 2) & 3))); }
__device__ __forceinline__ void load_tile128(LAS unsigned char* img, const bf16_t* g, size_t pitch, int tid, int zrows) {
#pragma unroll
    for (int i = 0; i < 4; ++i) { const int n = tid + 512 * i, row = n >> 4, ch = n & 15;
        u32x4 v = (u32x4){0u, 0u, 0u, 0u};
        if (row >= zrows) v = *(const u32x4*)(g + (size_t)(row - zrows) * pitch + ch * 8);
        *(LAS u32x4*)(img + off_b(row, ch)) = v; }
}
__device__ __forceinline__ bf16x8 tr_read2(unsigned a0, unsigned a1) {
    s16x4 r0, r1;
    asm volatile("ds_read_b64_tr_b16 %0, %2\n\tds_read_b64_tr_b16 %1, %3\n\ts_waitcnt lgkmcnt(0)" : "=&v"(r0), "=&v"(r1) : "v"(a0), "v"(a1) : "memory");
    bf16x8 o; o[0] = r0[0]; o[1] = r0[1]; o[2] = r0[2]; o[3] = r0[3]; o[4] = r1[0]; o[5] = r1[1]; o[6] = r1[2]; o[7] = r1[3]; return o;
}

__device__ __forceinline__ void kv_compute(LAS unsigned char* lds, float* dst, float scale, int w, int lane) {
    const unsigned bK = (unsigned)(uintptr_t)lds, bV = bK + 32768u;
    const unsigned g = lane >> 4, q = (lane & 15) >> 2, p = lane & 3;
    bf16x8 Kf[4];
#pragma unroll
    for (int ks = 0; ks < 4; ++ks) Kf[ks] = tr_read2(bK + off_b(32 * ks + 8 * g + q, 2 * w + (p >> 1)) + 8 * (p & 1), bK + off_b(32 * ks + 8 * g + 4 + q, 2 * w + (p >> 1)) + 8 * (p & 1));
#pragma unroll
    for (int et = 0; et < 8; ++et) {
        f32x4 acc = (f32x4){0.f, 0.f, 0.f, 0.f};
#pragma unroll
        for (int ks = 0; ks < 4; ++ks) {
            const bf16x8 Vf = tr_read2(bV + off_b(32 * ks + 8 * g + q, 2 * et + (p >> 1)) + 8 * (p & 1), bV + off_b(32 * ks + 8 * g + 4 + q, 2 * et + (p >> 1)) + 8 * (p & 1));
            acc = __builtin_amdgcn_mfma_f32_16x16x32_bf16(Vf, Kf[ks], acc, 0, 0, 0);
        }
        *(f32x4*)(dst + (size_t)(16 * w + (lane & 15)) * 128 + 16 * et + 4 * g) = acc * scale;
    }
}

__device__ __forceinline__ void ln8_stats(const float (&y)[8], float (&mu)[8], float (&rs)[8], LAS f32x2* red, int w, int lane) {
#pragma unroll
    for (int t = 0; t < 8; ++t) { const float s = wave_sum(y[t]), qq = wave_sum(y[t] * y[t]); if (lane == 0) red[w * 8 + t] = (f32x2){s, qq}; }
    __syncthreads();
#pragma unroll
    for (int t = 0; t < 8; ++t) { float s = 0.f, qq = 0.f;
#pragma unroll
        for (int ww = 0; ww < 8; ++ww) { const f32x2 v = red[ww * 8 + t]; s += v.x; qq += v.y; }
        const float m = s * (1.f / CC); float var = qq * (1.f / CC) - m * m; var = var < 0.f ? 0.f : var; mu[t] = m; rs[t] = 1.0f / sqrtf(var + EPS); }
    __syncthreads();
}


#define XB_TMO      128
#define XB_XCNT(j)  (256  + 64 * (j))
#define XB_XSUB(j)  (1280 + 64 * (j))
#define XB_XGEN(j)  (2304 + 64 * (j))
#define XB_TOP      3328
#define XB_TOPGEN   3392
#define XCD_BAR_WORDS 3456
#define XB_SPIN_CAP (1u << 22)
__device__ __forceinline__ unsigned xb_ld(unsigned* p)              { return __hip_atomic_load(p, __ATOMIC_RELAXED, __HIP_MEMORY_SCOPE_AGENT); }
__device__ __forceinline__ unsigned xb_add(unsigned* p, unsigned v) { return __hip_atomic_fetch_add(p, v, __ATOMIC_RELAXED, __HIP_MEMORY_SCOPE_AGENT); }
__device__ __forceinline__ unsigned xb_xcc_id() { return (unsigned)__builtin_amdgcn_s_getreg((3 << 11) | 20) & 0xFu; }
#define XB_SPIN(cond, bar) do { unsigned _sp = 0; while (cond) { __builtin_amdgcn_s_sleep(1); \
    if ((++_sp & 255u) == 0u) { if (xb_ld(&(bar)[XB_TMO])) break; if (_sp > XB_SPIN_CAP) { atomicAdd(&(bar)[XB_TMO], 1u); break; } } } } while (0)
struct XcdBarrier { unsigned* bar; unsigned x; volatile LAS unsigned* st; };
__device__ __forceinline__ XcdBarrier xcd_barrier_post(unsigned* bar, volatile LAS unsigned* st) {
    XcdBarrier b; b.bar = bar; b.x = xb_xcc_id(); b.st = st;
    if (threadIdx.x == 0) (void)xb_add(&bar[XB_XCNT(b.x)], 1u);
    return b;
}
__device__ __forceinline__ void xcd_barrier_complete(unsigned* bar, unsigned x, unsigned& nloc, unsigned& nx) {
    const unsigned G = gridDim.x * gridDim.y * gridDim.z;
    unsigned sum, cnt, mine, sp = 0u;
    for (;;) {
        sum = 0u; cnt = 0u; mine = 0u;
#pragma unroll
        for (unsigned j = 0; j < 16; ++j) { const unsigned c = xb_ld(&bar[XB_XCNT(j)]); sum += c; cnt += (c > 0u) ? 1u : 0u; mine = (j == x) ? c : mine; }
        if (sum == G) break;
        __builtin_amdgcn_s_sleep(1);
        if ((++sp & 255u) == 0u) { if (xb_ld(&bar[XB_TMO])) break; if (sp > XB_SPIN_CAP) { atomicAdd(&bar[XB_TMO], 1u); break; } }
    }
    nloc = mine > 0u ? mine : 1u; nx = cnt > 0u ? cnt : 1u;
}
__device__ __forceinline__ void xcd_barrier(const XcdBarrier& b) {
    asm volatile("s_waitcnt vmcnt(0)" ::: "memory");
    __syncthreads();
    if (threadIdx.x == 0) {
        unsigned* bar = b.bar;
        __builtin_amdgcn_s_waitcnt(0);
        unsigned nloc = b.st[0], nx = b.st[1];
        if (nloc == 0u) { xcd_barrier_complete(bar, b.x, nloc, nx); b.st[0] = nloc; b.st[1] = nx; }
        const unsigned old = xb_add(&bar[XB_XSUB(b.x)], 1u);
        const unsigned gen = old / nloc;
        if (old + 1u == (gen + 1u) * nloc) {
            __builtin_amdgcn_fence(__ATOMIC_RELEASE, "agent");
            asm volatile("s_waitcnt vmcnt(0)" ::: "memory");
            const unsigned og = xb_add(&bar[XB_TOP], 1u);
            const unsigned tg = og / nx;
            if (og + 1u == (tg + 1u) * nx) xb_add(&bar[XB_TOPGEN], 1u);
            else XB_SPIN(xb_ld(&bar[XB_TOPGEN]) == tg, bar);
            __builtin_amdgcn_fence(__ATOMIC_ACQUIRE, "agent");
            xb_add(&bar[XB_XGEN(b.x)], 1u);
            asm volatile("s_waitcnt vmcnt(0)" ::: "memory");
        } else {
            XB_SPIN(xb_ld(&bar[XB_XGEN(b.x)]) == gen, bar);
            __builtin_amdgcn_fence(__ATOMIC_ACQUIRE, "agent");
            asm volatile("s_waitcnt vmcnt(0)" ::: "memory");
        }
    }
    __syncthreads();
}
#ifndef REP_MASK
#define REP_MASK 0
#endif
#ifndef EXTRA_SYNCS
#define EXTRA_SYNCS 0
#endif
#define REP_BEGIN(k) { int nrep_ = 1 + ((REP_MASK >> (k)) & 1); asm volatile("" : "+s"(nrep_)); for (int rep_ = 0; rep_ < nrep_; ++rep_) { if (rep_) GRID_SYNC();
#define REP_END } }
struct Args { const float* in[17]; float* out; unsigned char* ws; };

__global__ void __launch_bounds__(512, 2) mk_fwd(Args a) {
    extern __shared__ __attribute__((aligned(16))) unsigned char lds_raw[];
    LAS unsigned char* lds = (LAS unsigned char*)lds_raw;
    cg::grid_group grid = cg::this_grid();
    if (a.ws == nullptr) grid.sync();
    volatile LAS unsigned* bst = (volatile LAS unsigned*)(lds + 131072 + 64);
    if (threadIdx.x < 2) bst[threadIdx.x] = 0u;
    __syncthreads();
    const XcdBarrier xbar = xcd_barrier_post((unsigned*)(a.ws + WS_CTL), bst);
#define GRID_SYNC() xcd_barrier(xbar)
#define PHASE_IDS int tid = threadIdx.x; asm volatile("" : "+v"(tid)); const int lane = tid & 63, w = __builtin_amdgcn_readfirstlane(tid >> 6); (void)lane; (void)w;
    const int G = gridDim.x, bx = blockIdx.x;
    unsigned char* ws = a.ws; float* out = a.out;
    const float* x_prompt = a.in[0]; const float* x_sample = a.in[1]; const float* state_ret = a.in[2]; const float* state_conv = a.in[3]; const float* meta = a.in[4];
    const float* g_mix_pre = a.in[5]; const float* g_mix_post = a.in[6]; const float* g_ffn_pre = a.in[7]; const float* g_ffn_post = a.in[8];
    const float* w_in = a.in[9]; const float* conv_w = a.in[10]; const float* conv_b = a.in[11]; const float* ln_g = a.in[12]; const float* ln_b = a.in[13];
    const float* w_out = a.in[14]; const float* w_ffn_in = a.in[15]; const float* w_ffn_out = a.in[16];
    f32x2* ROPE = (f32x2*)(ws + WS_ROPE);
    bf16_t* W1T = (bf16_t*)(ws + WS_W1T); bf16_t* WOT = (bf16_t*)(ws + WS_WOT); bf16_t* W3T = (bf16_t*)(ws + WS_W3T); bf16_t* W4T = (bf16_t*)(ws + WS_W4T);
    bf16_t* XN = (bf16_t*)(ws + WS_XN);
    bf16_t* Qb = (bf16_t*)(ws + WS_Q); bf16_t* Kb = (bf16_t*)(ws + WS_K); bf16_t* Vb = (bf16_t*)(ws + WS_V); bf16_t* SGb = (bf16_t*)(ws + WS_SG); bf16_t* Ub = (bf16_t*)(ws + WS_U);
    bf16_t* MIXIN = (bf16_t*)(ws + WS_MIXIN); float* KV = (float*)(ws + WS_KV); bf16_t* RP = (bf16_t*)(ws + WS_RP); bf16_t* MIX = (bf16_t*)(ws + WS_MIX);
    bf16_t* ACT = (bf16_t*)(ws + WS_ACT); bf16_t* FFN = (bf16_t*)(ws + WS_FFN);

    REP_BEGIN(0) {
        PHASE_IDS
        LAS float* scr = (LAS float*)(lds + w * 16384);
        const int gw = bx * 8 + w, NGW = G * 8;
        constexpr int I1 = (D / 64) * (INC / 32), IO = (D / 64) * (D / 32), I3 = (D / 64) * (2 * FF / 32), I4 = (FF / 64) * (D / 32);
        for (int it = gw; it < I1 + IO + I3 + I4; it += NGW) {
            int r = it;
            if (r < I1) { p0_transpose_item<1>(w_in, D, INC, W1T, scr, r, lane); continue; } r -= I1;
            if (r < IO) { p0_transpose_item<0>(w_out, D, D, WOT, scr, r, lane); continue; } r -= IO;
            if (r < I3) { p0_transpose_item<2>(w_ffn_in, D, 2 * FF, W3T, scr, r, lane); continue; } r -= I3;
            p0_transpose_item<0>(w_ffn_out, FF, D, W4T, scr, r, lane);
        }
        for (int m = gw; m < MP; m += NGW) {
            bf16_t* orow = XN + (size_t)m * D;
            if (m < ROW_S) rms_row_to_bf16(x_prompt + (size_t)m * D, g_mix_pre, orow, lane);
            else if (m < ROW_M) rms_row_to_bf16(x_sample + (size_t)(m - ROW_S) * D, g_mix_pre, orow, lane);
            else if (m < ROW_E) rms_row_to_bf16(meta + (size_t)(m - ROW_M) * D, g_mix_pre, orow, lane);
            else { u32x2* o8 = (u32x2*)orow + lane;
#pragma unroll
                for (int j = 0; j < 4; ++j) o8[64 * j] = (u32x2){0u, 0u}; }
        }
        for (int idx = bx * 512 + tid; idx < 2065 * 64; idx += G * 512) {
            const int pi = idx >> 6, j = idx & 63;
            const float posf = pi == 2064 ? 16384.f : (float)pi;
            const float lin = (float)j / 63.0f;
            const float pw = (float)exp2((double)lin * 13.287712379549449);
            const float inv = 1.0f / pw;
            float s, c; sincos_acc(posf * inv, s, c);
            ROPE[idx] = (f32x2){c, s};
        }
    } REP_END
    GRID_SYNC();

    for (int es_ = 0; es_ < EXTRA_SYNCS; ++es_) GRID_SYNC();
    REP_BEGIN(1) {
        pg8::Gemm g{XN, W1T, MP, INC, D}; pg8::StaticOrder S; S.init(MP, INC, G, bx);
        EpiProj E{Qb, Kb, Vb, SGb, Ub, ROPE, out};
        pg8::gemm_phase<EpiProj>(lds, g, S, E);
    } REP_END
    GRID_SYNC();

    REP_BEGIN(2) {
        PHASE_IDS
        constexpr int N_KV = 512, N_KVM = 4, N_SR = NS * NH, N_CP = ROW_S / 32, N_CS = NS;
        constexpr int I_KVM = N_KV, I_SR = I_KVM + N_KVM, I_CP = I_SR + N_SR, I_CS = I_CP + N_CP, I_END = I_CS + N_CS;
        for (int it = bx; it < I_SR; it += G) {
            {
                const bool ismeta = it >= I_KVM;
                const int h = ismeta ? it - I_KVM : (it >> 4) & 3;
                const int row0 = ismeta ? ROW_M : (it >> 6) * SEQ + (it & 15) * 128;
                __syncthreads();
                load_tile128(lds, Kb + (size_t)row0 * 512 + h * 128, 512, tid, ismeta ? 112 : 0);
                load_tile128(lds + 32768, Vb + (size_t)row0 * 512 + h * 128, 512, tid, ismeta ? 112 : 0);
                __syncthreads();
                kv_compute(lds, KV + (size_t)it * 16384, exp2f(lg2gamma(h) * 127.f), w, lane);
            }
        }
        for (int it = I_SR + bx; it < I_CP; it += G) {
            {
                const int sr = it - I_SR, i = sr >> 2, h = sr & 3, r = ROW_S + i;
                const int e4 = tid & 31, dg = tid >> 5;
                const float gam = exp2f(lg2gamma(h));
                const float* S0 = state_ret + (size_t)sr * 16384; float* S1 = out + OFF_RETS + (size_t)sr * 16384;
                const u32x2 vv = *(const u32x2*)(Vb + (size_t)r * 512 + h * 128 + 4 * e4);
                const f32x4 v4 = (f32x4){bflo(vv.x), bfhi(vv.x), bflo(vv.y), bfhi(vv.y)};
                f32x4 oacc = (f32x4){0.f, 0.f, 0.f, 0.f};
#pragma unroll
                for (int ii = 0; ii < 8; ++ii) { const int d = dg + 16 * ii;
                    const float kd = bf2f(Kb[(size_t)r * 512 + h * 128 + d]), qd = bf2f(Qb[(size_t)r * 512 + h * 128 + d]);
                    f32x4 s = *(const f32x4*)(S0 + d * 128 + 4 * e4);
                    s = s * gam + v4 * kd;
                    *(f32x4*)(S1 + d * 128 + 4 * e4) = s;
                    oacc += s * qd; }
                LAS float* red = (LAS float*)lds;
                __syncthreads();
                *(LAS f32x4*)(red + dg * 128 + 4 * e4) = oacc;
                __syncthreads();
                if (tid < 128) { float o = 0.f;
#pragma unroll
                    for (int k = 0; k < 16; ++k) o += red[k * 128 + tid];
                    const float ss = wave_sum(o * o);
                    if (lane == 0) red[2048 + w] = ss;
                    red[2304 + tid] = o; }
                __syncthreads();
                if (tid < 128) { const float ss = red[2048] + red[2049]; const float o = red[2304 + tid] * (1.0f / sqrtf(ss * (1.f / HD) + EPS));
                    const float sg = bf2f(SGb[(size_t)r * 512 + h * 128 + tid]);
                    MIXIN[(size_t)r * 1024 + h * 128 + tid] = (bf16_t)(cvt_pk_bf16(o * sg, 0.f) & 0xffffu); }
            }
        }
        for (int it = I_CP + bx; it < I_CS; it += G) {
            {
                const int ct = it - I_CP, b = ct >> 6, s0 = (ct & 63) * 32;
                LAS bf16_t* ub = (LAS bf16_t*)lds;
                LAS float* ybuf = (LAS float*)(lds + 65536);
                LAS f32x2* stats = (LAS f32x2*)(lds + 98304);
                __syncthreads();
#pragma unroll
                for (int i8 = 0; i8 < 8; ++i8) { const int n = tid + 512 * i8; const int rho = n >> 6, ch = n & 63; const int P = 16 + s0 - 30 + rho;
                    u32x4 v = (u32x4){0u, 0u, 0u, 0u};
                    if (n < 62 * 64) {
                        if (P >= 0) { const int row = P < 16 ? ROW_M + P : b * SEQ + P - 16; v = *(const u32x4*)(Ub + (size_t)row * 512 + ch * 8); }
                        *(LAS u32x4*)(ub + rho * 512 + ch * 8) = v; } }
                float wj[31];
#pragma unroll
                for (int j = 0; j < 31; ++j) wj[j] = conv_w[j * 512 + tid];
                const float cb = conv_b[tid], lg = ln_g[tid], lb = ln_b[tid];
                __syncthreads();
                for (int grp = 0; grp < 2; ++grp) {
                    float win[46];
#pragma unroll
                    for (int k = 0; k < 46; ++k) win[k] = bf2f(ub[(grp * 16 + k) * 512 + tid]);
                    float y[16];
#pragma unroll
                    for (int t = 0; t < 16; ++t) { float acc = cb;
#pragma unroll
                        for (int j = 0; j < 31; ++j) acc += wj[j] * win[t + j];
                        y[t] = acc; ybuf[t * 512 + tid] = acc; }
                    __syncthreads();
                    { float sA = 0.f, qA = 0.f, sB = 0.f, qB = 0.f;
#pragma unroll
                      for (int k = 0; k < 8; ++k) { const float vA = ybuf[w * 512 + lane + 64 * k], vB = ybuf[(w + 8) * 512 + lane + 64 * k]; sA += vA; qA += vA * vA; sB += vB; qB += vB * vB; }
#pragma unroll
                      for (int o = 1; o < 64; o <<= 1) { const float a0 = __shfl_xor(sA, o), a1 = __shfl_xor(qA, o), a2 = __shfl_xor(sB, o), a3 = __shfl_xor(qB, o); sA += a0; qA += a1; sB += a2; qB += a3; }
                      if (lane == 0) { const float mA = sA * (1.f / CC), mB = sB * (1.f / CC); float vA = qA * (1.f / CC) - mA * mA, vB = qB * (1.f / CC) - mB * mB; vA = vA < 0.f ? 0.f : vA; vB = vB < 0.f ? 0.f : vB;
                          stats[w] = (f32x2){mA, 1.0f / sqrtf(vA + EPS)}; stats[w + 8] = (f32x2){mB, 1.0f / sqrtf(vB + EPS)}; } }
                    __syncthreads();
#pragma unroll
                    for (int t = 0; t < 16; ++t) { const f32x2 st = stats[t]; const float yn = (y[t] - st.x) * st.y * lg + lb; const int row = b * SEQ + s0 + grp * 16 + t;
                        MIXIN[(size_t)row * 1024 + 512 + tid] = (bf16_t)(cvt_pk_bf16(silu_f(yn), 0.f) & 0xffffu); }
                }
            }
        }
        for (int it = I_CS + bx; it < I_END; it += G) {
            {
                const int i = it - I_CS;
                LAS f32x2* red = (LAS f32x2*)(lds + 65536);
                float wj[31];
#pragma unroll
                for (int j = 0; j < 31; ++j) wj[j] = conv_w[j * 512 + tid];
                const float cb = conv_b[tid], lg = ln_g[tid], lb = ln_b[tid];
                float acc = cb;
                const float* bufp = state_conv + (size_t)i * 30 * 512 + tid; float* op = out + OFF_CONVS + (size_t)i * 30 * 512 + tid;
#pragma unroll
                for (int j = 0; j < 30; ++j) { const float bv = bufp[j * 512]; acc += wj[j] * bv; if (j >= 1) op[(j - 1) * 512] = bv; }
                acc += wj[30] * bf2f(Ub[(size_t)(ROW_S + i) * 512 + tid]);
                float s = acc, q = acc * acc;
#pragma unroll
                for (int o = 1; o < 64; o <<= 1) { const float a0 = __shfl_xor(s, o), a1 = __shfl_xor(q, o); s += a0; q += a1; }
                __syncthreads();
                if (lane == 0) red[w] = (f32x2){s, q};
                __syncthreads();
                float ts = 0.f, tq = 0.f;
#pragma unroll
                for (int ww = 0; ww < 8; ++ww) { const f32x2 v = red[ww]; ts += v.x; tq += v.y; }
                const float m = ts * (1.f / CC); float var = tq * (1.f / CC) - m * m; var = var < 0.f ? 0.f : var;
                const float yn = (acc - m) * (1.0f / sqrtf(var + EPS)) * lg + lb;
                MIXIN[(size_t)(ROW_S + i) * 1024 + 512 + tid] = (bf16_t)(cvt_pk_bf16(silu_f(yn), 0.f) & 0xffffu);
            }
        }
    } REP_END
    GRID_SYNC();

    REP_BEGIN(3) {
        PHASE_IDS
        for (int idx = bx * 512 + tid; idx < 32 * 4096; idx += G * 512) {
            const int bh = idx >> 12, rem = idx & 4095, h = bh & 3;
            const float lg2 = lg2gamma(h), gam = exp2f(lg2), Gam = exp2f(lg2 * 128.f);
            f32x4 R = *(const f32x4*)(KV + (size_t)(512 + h) * 16384 + rem * 4);
            for (int c = 0; c < 16; ++c) {
                const f32x4 rs = R * gam; u32x2 o; o.x = cvt_pk_bf16(rs[0], rs[1]); o.y = cvt_pk_bf16(rs[2], rs[3]);
                *(u32x2*)(RP + (size_t)(bh * 16 + c) * 16384 + rem * 4) = o;
                R = R * Gam + *(const f32x4*)(KV + (size_t)(bh * 16 + c) * 16384 + rem * 4);
            }
            *(f32x4*)(out + OFF_RETP + (size_t)bh * 16384 + rem * 4) = R;
        }
    } REP_END
    GRID_SYNC();

    REP_BEGIN(4) {
        PHASE_IDS
        const unsigned bQ = (unsigned)(uintptr_t)lds, bKi = bQ + 32768u, bV = bQ + 65536u, bR = bQ + 98304u;
        const unsigned g = lane >> 4, q = (lane & 15) >> 2, p = lane & 3, fr = lane & 15;
        for (int it = bx; it < 512; it += G) {
            const int b = it >> 6, h = (it >> 4) & 3, c = it & 15;
            const int row0 = b * SEQ + c * 128;
            __syncthreads();
            load_tile128(lds, Qb + (size_t)row0 * 512 + h * 128, 512, tid, 0);
            load_tile128(lds + 32768, Kb + (size_t)row0 * 512 + h * 128, 512, tid, 0);
            load_tile128(lds + 65536, Vb + (size_t)row0 * 512 + h * 128, 512, tid, 0);
            load_tile128(lds + 98304, RP + (size_t)it * 16384, 128, tid, 0);
            __syncthreads();
            bf16x8 Qf[4];
#pragma unroll
            for (int s = 0; s < 4; ++s) Qf[s] = *(const LAS bf16x8*)(lds + off_b(fr + 16 * w, 4 * s + g));
            f32x4 accO[8];
#pragma unroll
            for (int et = 0; et < 8; ++et) {
                f32x4 acc = (f32x4){0.f, 0.f, 0.f, 0.f};
#pragma unroll
                for (int ks = 0; ks < 4; ++ks) {
                    const bf16x8 Rf = tr_read2(bR + off_b(32 * ks + 8 * g + q, 2 * et + (p >> 1)) + 8 * (p & 1), bR + off_b(32 * ks + 8 * g + 4 + q, 2 * et + (p >> 1)) + 8 * (p & 1));
                    acc = __builtin_amdgcn_mfma_f32_16x16x32_bf16(Rf, Qf[ks], acc, 0, 0, 0);
                }
                accO[et] = acc;
            }
            for (int jp = 0; 2 * jp <= w; ++jp) {
                const int ja = 2 * jp, jb = 2 * jp + 1;
                f32x4 sa = (f32x4){0.f, 0.f, 0.f, 0.f}, sb = (f32x4){0.f, 0.f, 0.f, 0.f};
#pragma unroll
                for (int s = 0; s < 4; ++s) { const bf16x8 Kf = *(const LAS bf16x8*)(lds + 32768 + off_b(fr + 16 * ja, 4 * s + g)); sa = __builtin_amdgcn_mfma_f32_16x16x32_bf16(Kf, Qf[s], sa, 0, 0, 0); }
                if (jb <= w) {
#pragma unroll
                    for (int s = 0; s < 4; ++s) { const bf16x8 Kf = *(const LAS bf16x8*)(lds + 32768 + off_b(fr + 16 * jb, 4 * s + g)); sb = __builtin_amdgcn_mfma_f32_16x16x32_bf16(Kf, Qf[s], sb, 0, 0, 0); }
                }
                if (ja == w) {
#pragma unroll
                    for (int rg = 0; rg < 4; ++rg) if (4 * g + rg > fr) sa[rg] = 0.f; }
                if (jb == w) {
#pragma unroll
                    for (int rg = 0; rg < 4; ++rg) if (4 * g + rg > fr) sb[rg] = 0.f; }
                bf16x8 Pf;
                { const unsigned p0 = cvt_pk_bf16(sa[0], sa[1]), p1 = cvt_pk_bf16(sa[2], sa[3]), p2 = cvt_pk_bf16(sb[0], sb[1]), p3 = cvt_pk_bf16(sb[2], sb[3]);
                  Pf[0] = (short)(p0 & 0xffff); Pf[1] = (short)(p0 >> 16); Pf[2] = (short)(p1 & 0xffff); Pf[3] = (short)(p1 >> 16);
                  Pf[4] = (short)(p2 & 0xffff); Pf[5] = (short)(p2 >> 16); Pf[6] = (short)(p3 & 0xffff); Pf[7] = (short)(p3 >> 16); }
#pragma unroll
                for (int et = 0; et < 8; ++et) {
                    const bf16x8 Vf = tr_read2(bV + off_b(32 * jp + 4 * g + q, 2 * et + (p >> 1)) + 8 * (p & 1), bV + off_b(32 * jp + 16 + 4 * g + q, 2 * et + (p >> 1)) + 8 * (p & 1));
                    accO[et] = __builtin_amdgcn_mfma_f32_16x16x32_bf16(Vf, Pf, accO[et], 0, 0, 0);
                }
            }
            float ss = 0.f;
#pragma unroll
            for (int et = 0; et < 8; ++et) ss += (accO[et][0] * accO[et][0] + accO[et][1] * accO[et][1]) + (accO[et][2] * accO[et][2] + accO[et][3] * accO[et][3]);
            ss += __shfl_xor(ss, 16); ss += __shfl_xor(ss, 32);
            const float rstd = 1.0f / sqrtf(ss * (1.f / HD) + EPS);
            const int row = row0 + 16 * w + fr;
#pragma unroll
            for (int et = 0; et < 8; ++et) {
                const u32x2 sg = *(const u32x2*)(SGb + (size_t)row * 512 + h * 128 + 16 * et + 4 * g);
                u32x2 o; o.x = cvt_pk_bf16(accO[et][0] * rstd * bflo(sg.x), accO[et][1] * rstd * bfhi(sg.x)); o.y = cvt_pk_bf16(accO[et][2] * rstd * bflo(sg.y), accO[et][3] * rstd * bfhi(sg.y));
                *(u32x2*)(MIXIN + (size_t)row * 1024 + h * 128 + 16 * et + 4 * g) = o;
            }
        }
        __syncthreads();
    } REP_END
    GRID_SYNC();

    REP_BEGIN(5) {
        pg8::Gemm g{MIXIN, WOT, MP, D, D}; pg8::StaticOrder S; S.init(MP, D, G, bx);
        EpiPlain E{MIX, D};
        pg8::gemm_phase<EpiPlain>(lds, g, S, E);
    } REP_END
    GRID_SYNC();

    REP_BEGIN(6) {
        PHASE_IDS
        const int gw = bx * 8 + w, NGW = G * 8;
        for (int m = gw; m < ROW_M; m += NGW) {
            const float* hrow = m < ROW_S ? x_prompt + (size_t)m * D : x_sample + (size_t)(m - ROW_S) * D;
            const f32x4* xr = (const f32x4*)hrow + lane; const u32x2* mr = (const u32x2*)(MIX + (size_t)m * D) + lane;
            f32x4 mv[4]; float s = 0.f;
#pragma unroll
            for (int j = 0; j < 4; ++j) { const u32x2 t = mr[64 * j]; mv[j] = (f32x4){bflo(t.x), bfhi(t.x), bflo(t.y), bfhi(t.y)}; s += (mv[j].x * mv[j].x + mv[j].y * mv[j].y) + (mv[j].z * mv[j].z + mv[j].w * mv[j].w); }
            const float rstd1 = 1.0f / sqrtf(wave_sum(s) * (1.f / D) + EPS);
            f32x4 hv[4]; float s2 = 0.f;
#pragma unroll
            for (int j = 0; j < 4; ++j) { const f32x4 gp = ((const f32x4*)g_mix_post + lane)[64 * j]; hv[j] = xr[64 * j] + mv[j] * rstd1 * gp;
                s2 += (hv[j].x * hv[j].x + hv[j].y * hv[j].y) + (hv[j].z * hv[j].z + hv[j].w * hv[j].w);
                ((f32x4*)(out + (size_t)m * D) + lane)[64 * j] = hv[j]; }
            const float rstd2 = 1.0f / sqrtf(wave_sum(s2) * (1.f / D) + EPS);
            u32x2* o8 = (u32x2*)(XN + (size_t)m * D) + lane;
#pragma unroll
            for (int j = 0; j < 4; ++j) { const f32x4 gp = ((const f32x4*)g_ffn_pre + lane)[64 * j]; u32x2 o; o.x = cvt_pk_bf16(hv[j].x * rstd2 * gp.x, hv[j].y * rstd2 * gp.y); o.y = cvt_pk_bf16(hv[j].z * rstd2 * gp.z, hv[j].w * rstd2 * gp.w); o8[64 * j] = o; }
        }
    } REP_END
    GRID_SYNC();

    REP_BEGIN(7) {
        pg8::Gemm g{XN, W3T, MP, 2 * FF, D}; pg8::StaticOrder S; S.init(MP, 2 * FF, G, bx);
        EpiGlu E{ACT};
        pg8::gemm_phase<EpiGlu>(lds, g, S, E);
    } REP_END
    GRID_SYNC();

    REP_BEGIN(8) {
        pg8::Gemm g{ACT, W4T, MP, D, FF}; pg8::StaticOrder S; S.init(MP, D, G, bx);
        EpiPlain E{FFN, D};
        pg8::gemm_phase<EpiPlain>(lds, g, S, E);
    } REP_END
    GRID_SYNC();

    REP_BEGIN(9) {
        PHASE_IDS
        const int gw = bx * 8 + w, NGW = G * 8;
        for (int m = gw; m < ROW_M; m += NGW) {
            const u32x2* fr2 = (const u32x2*)(FFN + (size_t)m * D) + lane;
            f32x4 fv[4]; float s = 0.f;
#pragma unroll
            for (int j = 0; j < 4; ++j) { const u32x2 t = fr2[64 * j]; fv[j] = (f32x4){bflo(t.x), bfhi(t.x), bflo(t.y), bfhi(t.y)}; s += (fv[j].x * fv[j].x + fv[j].y * fv[j].y) + (fv[j].z * fv[j].z + fv[j].w * fv[j].w); }
            const float rstd = 1.0f / sqrtf(wave_sum(s) * (1.f / D) + EPS);
            f32x4* orow = (f32x4*)(out + (size_t)m * D) + lane;
#pragma unroll
            for (int j = 0; j < 4; ++j) { const f32x4 gp = ((const f32x4*)g_ffn_post + lane)[64 * j]; orow[64 * j] = orow[64 * j] + fv[j] * rstd * gp; }
        }
    } REP_END
}

extern "C" void kernel_launch(void* const* d_in, const int* in_sizes, int n_in, void* d_out, int out_size, void* d_ws, size_t ws_size, hipStream_t stream) {
    static int grid = 0;
    if (grid == 0) {
        int dev = 0, cus = 0, per_cu = 0;
        hipGetDevice(&dev);
        hipDeviceGetAttribute(&cus, hipDeviceAttributeMultiprocessorCount, dev);
        hipFuncSetAttribute((const void*)mk_fwd, hipFuncAttributeMaxDynamicSharedMemorySize, LDS_BYTES);
        hipOccupancyMaxActiveBlocksPerMultiprocessor(&per_cu, (const void*)mk_fwd, 512, LDS_BYTES);
        if (per_cu < 1) per_cu = 1;
        grid = cus * per_cu;
        if (ws_size < WS_END || n_in != 17) { fprintf(stderr, "kernel_launch: unexpected ws %zu / n_in %d\n", ws_size, n_in); }
    }
    Args a{};
    for (int i = 0; i < 17; ++i) a.in[i] = (const float*)d_in[i];
    a.out = (float*)d_out; a.ws = (unsigned char*)d_ws;
    hipMemsetAsync((char*)d_ws + WS_CTL, 0, CTL_BYTES, stream);
    void* args[] = {&a};
    hipError_t e = hipLaunchCooperativeKernel((const void*)mk_fwd, dim3(grid), dim3(512), args, LDS_BYTES, stream);
    if (e != hipSuccess) fprintf(stderr, "cooperative launch failed: %s (grid %d)\n", hipGetErrorString(e), grid);
}
```

```cpp
#include <hip/hip_runtime.h>
#include <hip/hip_cooperative_groups.h>
#include <cstdio>
#include <cstdint>
namespace cg = cooperative_groups;

#define LAS __attribute__((address_space(3)))
typedef unsigned short bf16_t;
typedef short bf16x8 __attribute__((ext_vector_type(8)));
typedef short s16x4 __attribute__((ext_vector_type(4)));
typedef float f32x4 __attribute__((ext_vector_type(4)));
typedef float f32x2 __attribute__((ext_vector_type(2)));
typedef unsigned u32x4 __attribute__((ext_vector_type(4)));
typedef unsigned u32x2 __attribute__((ext_vector_type(2)));

constexpr int D = 1024, NB = 8, SEQ = 2048, NS = 128, NMETA = 16, NH = 4, HD = 128, RW = 512, CC = 512, CW = 31, FF = 2816, INC = 3072;
constexpr int ROW_S = NB * SEQ;
constexpr int ROW_M = ROW_S + NS;
constexpr int ROW_E = ROW_M + NMETA;
constexpr int MP = 16640;
constexpr float EPS = 1e-6f;
constexpr size_t OFF_YS = (size_t)ROW_S * D, OFF_RETP = OFF_YS + (size_t)NS * D, OFF_CONVP = OFF_RETP + (size_t)NB * NH * HD * HD,
                 OFF_RETS = OFF_CONVP + (size_t)NB * 30 * CC, OFF_CONVS = OFF_RETS + (size_t)NS * NH * HD * HD;
constexpr size_t KiB = 1024, MiB = 1u << 20;
constexpr size_t WS_ROPE = 0;
constexpr size_t WS_CTL = MiB + 512 * KiB, CTL_BYTES = 16384;
constexpr size_t WS_RS2 = MiB + 544 * KiB;
constexpr size_t WS_W1T = 2 * MiB, WS_WOT = 8 * MiB, WS_W3T = 10 * MiB, WS_W4T = 21 * MiB;
constexpr size_t WS_XN = 26 * MiB + 512 * KiB;
constexpr size_t SZ_QS = (size_t)MP * 512 * 2;
constexpr size_t WS_Q = 59 * MiB, WS_K = WS_Q + SZ_QS, WS_V = WS_K + SZ_QS, WS_SG = WS_V + SZ_QS, WS_U = WS_SG + SZ_QS;
constexpr size_t WS_MIXIN = WS_U + SZ_QS;
constexpr size_t WS_KV = WS_MIXIN + (size_t)MP * 1024 * 2;
constexpr size_t WS_RP = WS_KV + (size_t)516 * 65536;
constexpr size_t WS_MIX = WS_RP + (size_t)512 * 32768;
constexpr size_t WS_ACT = WS_Q;
constexpr size_t WS_FFN = WS_KV;
constexpr size_t WS_END = WS_MIX + (size_t)MP * 1024 * 2;
static_assert(WS_END <= 256 * MiB, "ws");
static_assert(WS_ACT + (size_t)MP * FF * 2 <= WS_KV, "act overlay");
static_assert(WS_FFN + (size_t)MP * 1024 * 2 <= WS_MIX, "ffn overlay");
constexpr int LDS_BYTES = 147456;

__device__ __forceinline__ unsigned cvt_pk_bf16(float lo, float hi) { unsigned r; asm volatile("v_cvt_pk_bf16_f32 %0, %1, %2" : "=v"(r) : "v"(lo), "v"(hi)); return r; }
__device__ __forceinline__ float bf2f(unsigned short b) { return __uint_as_float(((unsigned)b) << 16); }
__device__ __forceinline__ float bflo(unsigned w) { return __uint_as_float(w << 16); }
__device__ __forceinline__ float bfhi(unsigned w) { return __uint_as_float(w & 0xffff0000u); }
__device__ __forceinline__ float wave_sum(float v) {
#pragma unroll
    for (int o = 1; o < 64; o <<= 1) v += __shfl_xor(v, o);
    return v;
}
__device__ __forceinline__ float sigm_f(float x) { return __builtin_amdgcn_rcpf(1.0f + __builtin_amdgcn_exp2f(-1.4426950408889634f * x)); }
__device__ __forceinline__ float silu_f(float x) { return x * sigm_f(x); }
__device__ __forceinline__ float lg2gamma(int h) { return log2f(1.0f - exp2f(-5.0f - (float)h)); }

namespace pg8 {
constexpr int BM = 256, BK = 64, HALF = 128, HTB = HALF * BK * 2, STAGE_BYTES = 8 * HTB, NXCD = 8, WGM = 8;
__device__ __forceinline__ int lds_byte(int r, int c) { const int st = (r >> 4) * 2 + (c >> 5), rr = r & 15, cc = c & 31, ob = rr * 64 + cc * 2; return st * 1024 + (ob ^ (((ob >> 9) & 1) << 5)); }
__device__ __forceinline__ void stage_rc(int b, int& R, int& C) { const int st = b / 1024, sb = b % 1024, swz = sb ^ (((sb >> 9) & 1) << 5); R = (st >> 1) * 16 + swz / 64; C = (st & 1) * 32 + (swz % 64) / 2; }
__device__ __forceinline__ int perm32(int rho) { const int n = rho >> 4, i = rho & 15; return 8 * (i >> 2) + 4 * n + (i & 3); }
struct Unit { int pm, pn; };
struct Gemm { const bf16_t* A; const bf16_t* Bt; int M, N, K; };
struct StaticOrder {
    int nM, nN, nwg, G, c;
    __device__ void init(int M, int N, int G_, int c_) { nM = M / BM; nN = N / BM; nwg = nM * nN; G = G_; c = c_; }
    __device__ bool next(int i, Unit& u) const {
        const long L = (long)i * G + c; if (L >= nwg) return false;
        int wgid = (int)L; { const int q = nwg / NXCD, r = nwg % NXCD, xcd = wgid % NXCD, off = wgid / NXCD; wgid = (xcd < r ? xcd * (q + 1) : r * (q + 1) + (xcd - r) * q) + off; }
        const int nig = WGM * nN, gid = wgid / nig, fm = gid * WGM, gsz = (nM - fm) < WGM ? (nM - fm) : WGM;
        u.pm = fm + ((wgid % nig) % gsz); u.pn = (wgid % nig) / gsz; return true;
    }
};

template <class Epi>
__device__ __forceinline__ void gemm_phase(LAS unsigned char* lds, const Gemm g, const StaticOrder& S, const Epi& E) {
    int tid_ = threadIdx.x; asm volatile("" : "+v"(tid_));
    const int tid = tid_, wid = __builtin_amdgcn_readfirstlane(tid >> 6), lane = tid & 63, wr = wid >> 2, wc = wid & 3, fr = lane & 15, fq = lane >> 4;
    const int K = g.K, nt = K / BK;
    unsigned voffA[2], voffB[2];
#pragma unroll
    for (int i = 0; i < 2; ++i) { int R, C; stage_rc(tid * 16 + i * 8192, R, C); const int Rb = ((R & ~31) + perm32(R & 31));
        voffA[i] = (unsigned)(R * K + C) * 2u; voffB[i] = (unsigned)(Rb * K + C) * 2u; }
    const size_t kstep = (size_t)(BK * 2);
    const size_t hstep = (size_t)HALF * K * 2;
    const size_t tstep = 2 * hstep;
    const unsigned ldsw = (unsigned)wid * 1024u;
    const int aoff = lds_byte(wr * 64 + fr, fq * 8), boff = lds_byte(wc * 32 + fr, fq * 8);
#define PG8_SA(b, h) (((b) * 2 + (h)) * HTB)
#define PG8_SB(b, h) ((4 + (b) * 2 + (h)) * HTB)
#define PG8_STAGE(bufoff, gbase, voff) do { _Pragma("unroll") for (int _i = 0; _i < 2; ++_i) \
        __builtin_amdgcn_global_load_lds((const unsigned*)((const char*)(gbase) + (voff)[_i]), (LAS unsigned*)(lds + (bufoff) + ldsw + _i * 8192), 16, 0, 0); } while (0)
#define PG8_LDA(dst, b, h) do { _Pragma("unroll") for (int m = 0; m < 4; ++m) _Pragma("unroll") for (int k = 0; k < 2; ++k) dst[m][k] = *(const LAS bf16x8*)(lds + PG8_SA(b, h) + aoff + m * 2048 + k * 1024); } while (0)
#define PG8_LDB(dst, b, h) do { _Pragma("unroll") for (int n = 0; n < 2; ++n) _Pragma("unroll") for (int k = 0; k < 2; ++k) dst[n][k] = *(const LAS bf16x8*)(lds + PG8_SB(b, h) + boff + n * 2048 + k * 1024); } while (0)
#define PG8_MMA(ai, bj, At, Bt) do { __builtin_amdgcn_s_setprio(1); _Pragma("unroll") for (int m = 0; m < 4; ++m) _Pragma("unroll") for (int n = 0; n < 2; ++n) _Pragma("unroll") for (int k = 0; k < 2; ++k) \
        acc[ai][bj][m][n] = __builtin_amdgcn_mfma_f32_16x16x32_bf16(Bt[n][k], At[m][k], acc[ai][bj][m][n], 0, 0, 0); __builtin_amdgcn_s_setprio(0); } while (0)
#define PG8_WAIT_V(n) asm volatile("s_waitcnt vmcnt(" #n ")" ::: "memory")
#define PG8_WAIT_L(n) asm volatile("s_waitcnt lgkmcnt(" #n ")" ::: "memory")
#define PG8_BAR __builtin_amdgcn_s_barrier()
#define PG8_SCHED __builtin_amdgcn_sched_barrier(0)
    Unit cur, nxt; int ui = 0;
    if (!S.next(0, cur)) return;
    f32x4 acc[2][2][4][2];
#pragma unroll
    for (int a = 0; a < 2; ++a)
#pragma unroll
        for (int b = 0; b < 2; ++b)
#pragma unroll
            for (int m = 0; m < 4; ++m)
#pragma unroll
                for (int n = 0; n < 2; ++n) acc[a][b][m][n] = (f32x4){0.f, 0.f, 0.f, 0.f};
    bf16x8 At[4][2], B0[2][2], B1[2][2];
    const char* cA = (const char*)g.A + (size_t)cur.pm * tstep; const char* cB = (const char*)g.Bt + (size_t)cur.pn * tstep;
    PG8_STAGE(PG8_SB(0, 0), cB, voffB); PG8_STAGE(PG8_SB(0, 1), cB + hstep, voffB); PG8_STAGE(PG8_SA(0, 0), cA, voffA); PG8_STAGE(PG8_SA(0, 1), cA + hstep, voffA);
    if (wr == 1) PG8_BAR;
    PG8_WAIT_V(2); PG8_BAR;
    PG8_STAGE(PG8_SB(1, 0), cB + kstep, voffB); PG8_STAGE(PG8_SA(1, 0), cA + kstep, voffA); PG8_STAGE(PG8_SB(1, 1), cB + hstep + kstep, voffB);
    PG8_WAIT_V(6); PG8_BAR;
    for (;;) {
        const bool has_next = S.next(ui + 1, nxt);
        const char* nA = has_next ? (const char*)g.A + (size_t)nxt.pm * tstep : cA; const char* nB = has_next ? (const char*)g.Bt + (size_t)nxt.pn * tstep : cB;
        for (int t = 0; t < nt; t += 2) {
            const bool last = (t == nt - 2);
            const char* a1 = cA + (size_t)(t + 1) * kstep;
            const char* a2 = last ? nA : cA + (size_t)(t + 2) * kstep; const char* b2 = last ? nB : cB + (size_t)(t + 2) * kstep;
            const char* a3 = a2 + kstep; const char* b3 = b2 + kstep;
            PG8_LDB(B0, 0, 0); PG8_LDB(B1, 0, 1); PG8_SCHED; PG8_LDA(At, 0, 0); PG8_STAGE(PG8_SA(1, 1), a1 + hstep, voffA);
            PG8_WAIT_V(8); PG8_WAIT_L(0); PG8_BAR; PG8_MMA(0, 0, At, B0); PG8_MMA(0, 1, At, B1); PG8_BAR; PG8_SCHED;
            PG8_LDA(At, 0, 1); PG8_STAGE(PG8_SB(0, 0), b2, voffB); PG8_STAGE(PG8_SB(0, 1), b2 + hstep, voffB); PG8_STAGE(PG8_SA(0, 0), a2, voffA);
            PG8_WAIT_V(8); PG8_WAIT_L(0); PG8_BAR; PG8_MMA(1, 0, At, B0); PG8_MMA(1, 1, At, B1); PG8_BAR; PG8_SCHED;
            PG8_LDB(B0, 1, 0); PG8_LDB(B1, 1, 1); PG8_SCHED; PG8_LDA(At, 1, 0); PG8_STAGE(PG8_SA(0, 1), a2 + hstep, voffA);
            PG8_WAIT_V(8); PG8_WAIT_L(0); PG8_BAR; PG8_MMA(0, 0, At, B0); PG8_MMA(0, 1, At, B1); PG8_BAR; PG8_SCHED;
            PG8_LDA(At, 1, 1); PG8_STAGE(PG8_SB(1, 0), b3, voffB); PG8_STAGE(PG8_SB(1, 1), b3 + hstep, voffB); PG8_STAGE(PG8_SA(1, 0), a3, voffA);
            PG8_WAIT_V(8); PG8_WAIT_L(0); PG8_BAR; PG8_MMA(1, 0, At, B0); PG8_MMA(1, 1, At, B1); PG8_BAR; PG8_SCHED;
        }
        if (wr == 0) PG8_BAR;
        E(acc, cur, wr, wc, fr, fq);
        if (!has_next) break;
#pragma unroll
        for (int a = 0; a < 2; ++a)
#pragma unroll
            for (int b = 0; b < 2; ++b)
#pragma unroll
                for (int m = 0; m < 4; ++m)
#pragma unroll
                    for (int n = 0; n < 2; ++n) acc[a][b][m][n] = (f32x4){0.f, 0.f, 0.f, 0.f};
        cur = nxt; cA = nA; cB = nB; ++ui;
        if (wr == 1) PG8_BAR;
    }
    PG8_WAIT_V(0);
    PG8_BAR;
#undef PG8_SA
#undef PG8_SB
#undef PG8_STAGE
#undef PG8_LDA
#undef PG8_LDB
#undef PG8_MMA
#undef PG8_WAIT_V
#undef PG8_WAIT_L
#undef PG8_BAR
#undef PG8_SCHED
}
}

__device__ __forceinline__ u32x4 pack8(const f32x4 a, const f32x4 b) { u32x4 w; w.x = cvt_pk_bf16(a[0], a[1]); w.y = cvt_pk_bf16(a[2], a[3]); w.z = cvt_pk_bf16(b[0], b[1]); w.w = cvt_pk_bf16(b[2], b[3]); return w; }

struct EpiPlain {
    bf16_t* O; int ldc;
    __device__ __forceinline__ void row(int pn, int wc, int fq, int r, const f32x4& x1a, const f32x4& x1b, const f32x4& x2a, const f32x4& x2b) const {
        bf16_t* rowp = O + (size_t)r * ldc + pn * 256 + wc * 32 + 8 * fq;
        *(u32x4*)rowp = pack8(x1a, x1b); *(u32x4*)(rowp + 128) = pack8(x2a, x2b);
    }
    __device__ __forceinline__ void operator()(const f32x4 (&acc)[2][2][4][2], const pg8::Unit& u, int wr, int wc, int fr, int fq) const {
#pragma unroll
        for (int ai = 0; ai < 2; ++ai)
#pragma unroll
            for (int m = 0; m < 4; ++m) row(u.pn, wc, fq, u.pm * 256 + ai * 128 + wr * 64 + m * 16 + fr, acc[ai][0][m][0], acc[ai][0][m][1], acc[ai][1][m][0], acc[ai][1][m][1]);
    }
};
struct EpiGlu {
    bf16_t* O; const float* rs;
    __device__ __forceinline__ void row(int pn, int wc, int fq, int r, const f32x4& x1a, const f32x4& x1b, const f32x4& x2a, const f32x4& x2b) const {
        f32x4 o0, o1; const float sc = rs[r];
#pragma unroll
        for (int j = 0; j < 4; ++j) { o0[j] = silu_f(x1a[j] * sc) * (x2a[j] * sc); o1[j] = silu_f(x1b[j] * sc) * (x2b[j] * sc); }
        *(u32x4*)(O + (size_t)r * FF + pn * 128 + wc * 32 + 8 * fq) = pack8(o0, o1);
    }
    __device__ __forceinline__ void operator()(const f32x4 (&acc)[2][2][4][2], const pg8::Unit& u, int wr, int wc, int fr, int fq) const {
#pragma unroll
        for (int ai = 0; ai < 2; ++ai)
#pragma unroll
            for (int m = 0; m < 4; ++m) row(u.pn, wc, fq, u.pm * 256 + ai * 128 + wr * 64 + m * 16 + fr, acc[ai][0][m][0], acc[ai][0][m][1], acc[ai][1][m][0], acc[ai][1][m][1]);
    }
};
struct EpiProj {
    bf16_t *Q, *Kb, *V, *SG, *U; const f32x2* rope; float* out;
    __device__ __forceinline__ void row(int pn, int wc, int fq, int r, const f32x4& x1a, const f32x4& x1b, const f32x4& x2a, const f32x4& x2b) const {
        const int jj0 = wc * 32 + 8 * fq;
        if (pn < 4) {
            const int sec = pn >> 1, head = (pn & 1) * 2 + (wc >> 1), dlow = (wc & 1) * 32 + 8 * fq;
            const float lg2 = lg2gamma(head);
            bf16_t* dst = sec ? Kb : Q;
            int pidx, li;
            if (r < ROW_S) { pidx = 16 + (r & 2047); li = r & 127; }
            else if (r < ROW_M) { pidx = 2064; li = 0; }
            else if (r < ROW_E) { pidx = r - ROW_M; li = 112 + pidx; }
            else { pidx = 0; li = 0; }
            const float sc = sec ? 0.08838834764831845f * exp2f(-lg2 * (float)li) : exp2f(lg2 * (float)li);
            const f32x4* rp = (const f32x4*)(rope + (size_t)pidx * 64 + dlow);
            const f32x4 cs0 = rp[0], cs1 = rp[1], cs2 = rp[2], cs3 = rp[3];
            f32x4 o1a, o1b, o2a, o2b;
            o1a[0] = (x1a[0] * cs0[0] - x2a[0] * cs0[1]) * sc; o2a[0] = (x1a[0] * cs0[1] + x2a[0] * cs0[0]) * sc;
            o1a[1] = (x1a[1] * cs0[2] - x2a[1] * cs0[3]) * sc; o2a[1] = (x1a[1] * cs0[3] + x2a[1] * cs0[2]) * sc;
            o1a[2] = (x1a[2] * cs1[0] - x2a[2] * cs1[1]) * sc; o2a[2] = (x1a[2] * cs1[1] + x2a[2] * cs1[0]) * sc;
            o1a[3] = (x1a[3] * cs1[2] - x2a[3] * cs1[3]) * sc; o2a[3] = (x1a[3] * cs1[3] + x2a[3] * cs1[2]) * sc;
            o1b[0] = (x1b[0] * cs2[0] - x2b[0] * cs2[1]) * sc; o2b[0] = (x1b[0] * cs2[1] + x2b[0] * cs2[0]) * sc;
            o1b[1] = (x1b[1] * cs2[2] - x2b[1] * cs2[3]) * sc; o2b[1] = (x1b[1] * cs2[3] + x2b[1] * cs2[2]) * sc;
            o1b[2] = (x1b[2] * cs3[0] - x2b[2] * cs3[1]) * sc; o2b[2] = (x1b[2] * cs3[1] + x2b[2] * cs3[0]) * sc;
            o1b[3] = (x1b[3] * cs3[2] - x2b[3] * cs3[3]) * sc; o2b[3] = (x1b[3] * cs3[3] + x2b[3] * cs3[2]) * sc;
            bf16_t* rowp = dst + (size_t)r * 512 + head * 128 + dlow;
            *(u32x4*)rowp = pack8(o1a, o1b);
            *(u32x4*)(rowp + 64) = pack8(o2a, o2b);
        } else if (pn < 8) {
            bf16_t* dst = pn < 6 ? V : SG; const bool act = pn >= 6;
            const int colt = (pn & 1) * 256 + jj0;
            f32x4 a0 = x1a, b0 = x1b, a1 = x2a, b1 = x2b;
            if (act) {
#pragma unroll
                for (int j = 0; j < 4; ++j) { a0[j] = silu_f(a0[j]); b0[j] = silu_f(b0[j]); a1[j] = silu_f(a1[j]); b1[j] = silu_f(b1[j]); } }
            *(u32x4*)(dst + (size_t)r * 512 + colt) = pack8(a0, b0);
            *(u32x4*)(dst + (size_t)r * 512 + colt + 128) = pack8(a1, b1);
        } else {
            const int c0 = (pn - 8) * 128 + jj0;
            f32x4 o0, o1;
#pragma unroll
            for (int j = 0; j < 4; ++j) { o0[j] = x1a[j] * sigm_f(x2a[j]); o1[j] = x1b[j] * sigm_f(x2b[j]); }
            *(u32x4*)(U + (size_t)r * 512 + c0) = pack8(o0, o1);
            if (r < ROW_S) { const int s = r & 2047; if (s >= SEQ - 30) { float* p = out + OFF_CONVP + ((size_t)((r >> 11) * 30 + (s - (SEQ - 30))) * 512 + c0); *(f32x4*)p = o0; *(f32x4*)(p + 4) = o1; } }
            else if (r < ROW_M) { float* p = out + OFF_CONVS + ((size_t)((r - ROW_S) * 30 + 29) * 512 + c0); *(f32x4*)p = o0; *(f32x4*)(p + 4) = o1; }
        }
    }
    __device__ __forceinline__ void operator()(const f32x4 (&acc)[2][2][4][2], const pg8::Unit& u, int wr, int wc, int fr, int fq) const {
#pragma unroll
        for (int ai = 0; ai < 2; ++ai)
#pragma unroll
            for (int m = 0; m < 4; ++m) row(u.pn, wc, fq, u.pm * 256 + ai * 128 + wr * 64 + m * 16 + fr, acc[ai][0][m][0], acc[ai][0][m][1], acc[ai][1][m][0], acc[ai][1][m][1]);
    }
};

template <class Epi, int K>
__device__ __forceinline__ void skinny_phase(LAS unsigned char* lds, const bf16_t* A, const bf16_t* Bt, int npn, int nslab, int row_base, const Epi& E, int blk, int nblk) {
    int tid_ = threadIdx.x; asm volatile("" : "+v"(tid_));
    const int lane = tid_ & 63, w = __builtin_amdgcn_readfirstlane(tid_ >> 6), fr = lane & 15, fq = lane >> 4;
    constexpr int KSL = K / 8;
    static_assert(KSL % 32 == 0, "K slice");
    const int ntask = npn * 4 * nslab;
    LAS f32x4* red = (LAS f32x4*)lds;
    for (int task = blk; task < ntask; task += nblk) {
        const int slab = task % nslab, uu = task / nslab, wc = uu & 3, pn = uu >> 2;
        const bf16_t* ap = A + (size_t)(row_base + 16 * slab + fr) * K + 8 * fq + w * KSL;
        const bf16_t* b00 = Bt + (size_t)(pn * 256 + wc * 32 + pg8::perm32(fr)) * K + 8 * fq + w * KSL;
        const bf16_t* b01 = Bt + (size_t)(pn * 256 + wc * 32 + pg8::perm32(16 + fr)) * K + 8 * fq + w * KSL;
        const bf16_t* b10 = b00 + (size_t)128 * K; const bf16_t* b11 = b01 + (size_t)128 * K;
        f32x4 c00 = (f32x4){0.f, 0.f, 0.f, 0.f}, c01 = c00, c10 = c00, c11 = c00;
#pragma unroll
        for (int k = 0; k < KSL; k += 32) {
            const bf16x8 a = *(const bf16x8*)(ap + k);
            const bf16x8 w00 = *(const bf16x8*)(b00 + k), w01 = *(const bf16x8*)(b01 + k), w10 = *(const bf16x8*)(b10 + k), w11 = *(const bf16x8*)(b11 + k);
            c00 = __builtin_amdgcn_mfma_f32_16x16x32_bf16(w00, a, c00, 0, 0, 0);
            c01 = __builtin_amdgcn_mfma_f32_16x16x32_bf16(w01, a, c01, 0, 0, 0);
            c10 = __builtin_amdgcn_mfma_f32_16x16x32_bf16(w10, a, c10, 0, 0, 0);
            c11 = __builtin_amdgcn_mfma_f32_16x16x32_bf16(w11, a, c11, 0, 0, 0);
        }
        __syncthreads();
        red[(w * 4 + 0) * 64 + lane] = c00; red[(w * 4 + 1) * 64 + lane] = c01; red[(w * 4 + 2) * 64 + lane] = c10; red[(w * 4 + 3) * 64 + lane] = c11;
        __syncthreads();
        if (w == 0) {
#pragma unroll
            for (int ww = 1; ww < 8; ++ww) { c00 += red[(ww * 4 + 0) * 64 + lane]; c01 += red[(ww * 4 + 1) * 64 + lane]; c10 += red[(ww * 4 + 2) * 64 + lane]; c11 += red[(ww * 4 + 3) * 64 + lane]; }
            E.row(pn, wc, fq, row_base + 16 * slab + fr, c00, c01, c10, c11);
        }
    }
    __syncthreads();
}

__device__ __forceinline__ int src_w1(int n) {
    const int pn = n >> 8, j = n & 255, bj = j >> 7, jj = j & 127;
    if (pn < 4) { const int sec = pn >> 1, head = (pn & 1) * 2 + (jj >> 6), d = (jj & 63) + 64 * bj; return sec * 512 + head * 128 + d; }
    if (pn < 8) return n;
    return 2048 + 512 * bj + 128 * (pn - 8) + jj;
}
__device__ __forceinline__ int src_w3(int n) { const int pn = n >> 8, j = n & 255, bj = j >> 7, jj = j & 127; return FF * bj + 128 * pn + jj; }
template <int MODE>
__device__ __forceinline__ void p0_transpose_item(const float* W, int K, int N, bf16_t* WT, LAS float* scr, int item, int lane, const float* kgain = nullptr) {
    const int nblk = N / 32, kb = item / nblk, nb = item % nblk, k0 = 64 * kb, n0 = 32 * nb;
    const int s0 = MODE == 1 ? src_w1(n0) : MODE == 2 ? src_w3(n0) : n0;
    { const int kr = lane >> 3, c4 = lane & 7;
      f32x4 v[8];
#pragma unroll
      for (int i = 0; i < 8; ++i) v[i] = *(const f32x4*)(W + (size_t)(k0 + 8 * i + kr) * N + s0 + 4 * c4);
      if (kgain) {
#pragma unroll
          for (int i = 0; i < 8; ++i) v[i] = v[i] * kgain[k0 + 8 * i + kr]; }
#pragma unroll
      for (int i = 0; i < 8; ++i) { LAS float* sp = scr + (8 * i + kr) * 33 + 4 * c4; sp[0] = v[i].x; sp[1] = v[i].y; sp[2] = v[i].z; sp[3] = v[i].w; } }
    asm volatile("s_waitcnt lgkmcnt(0)" ::: "memory");
    const int c = lane & 7;
#pragma unroll
    for (int j = 0; j < 4; ++j) { const int n = (lane >> 3) + 8 * j; const LAS float* s = scr + (8 * c) * 33 + n;
        u32x4 o; o.x = cvt_pk_bf16(s[0 * 33], s[1 * 33]); o.y = cvt_pk_bf16(s[2 * 33], s[3 * 33]); o.z = cvt_pk_bf16(s[4 * 33], s[5 * 33]); o.w = cvt_pk_bf16(s[6 * 33], s[7 * 33]);
        *(u32x4*)(WT + (size_t)(n0 + n) * K + k0 + 8 * c) = o; }
    asm volatile("s_waitcnt lgkmcnt(0)" ::: "memory");
}
__device__ __forceinline__ void sincos_acc(float angf, float& s, float& c) {
    const double a = (double)angf; const double n = rint(a * 0.15915494309189535);
    double r = fma(-n, 6.283185307179586, a); r = fma(-n, 2.4492935982947064e-16, r);
    const double h = 0.5 * r, h2 = h * h;
    double sp = -1.0 / 1307674368000.0; sp = sp * h2 + 1.0 / 6227020800.0; sp = sp * h2 - 1.0 / 39916800.0; sp = sp * h2 + 1.0 / 362880.0; sp = sp * h2 - 1.0 / 5040.0; sp = sp * h2 + 1.0 / 120.0; sp = sp * h2 - 1.0 / 6.0; sp = sp * h2 + 1.0;
    const double sh = sp * h;
    double cp = 1.0 / 20922789888000.0; cp = cp * h2 - 1.0 / 87178291200.0; cp = cp * h2 + 1.0 / 479001600.0; cp = cp * h2 - 1.0 / 3628800.0; cp = cp * h2 + 1.0 / 40320.0; cp = cp * h2 - 1.0 / 720.0; cp = cp * h2 + 1.0 / 24.0; cp = cp * h2 - 0.5; cp = cp * h2 + 1.0;
    s = (float)(2.0 * sh * cp); c = (float)(1.0 - 2.0 * sh * sh);
}
__device__ __forceinline__ void rms_row_to_bf16(const float* xrow, const float* w, bf16_t* orow, int lane) {
    const f32x4* xr = (const f32x4*)xrow + lane; const f32x4* wr4 = (const f32x4*)w + lane;
    f32x4 v[4]; float s = 0.f;
#pragma unroll
    for (int j = 0; j < 4; ++j) { v[j] = xr[64 * j]; s += (v[j].x * v[j].x + v[j].y * v[j].y) + (v[j].z * v[j].z + v[j].w * v[j].w); }
    const float rstd = 1.0f / sqrtf(wave_sum(s) * (1.f / D) + EPS);
    u32x2* o8 = (u32x2*)orow + lane;
#pragma unroll
    for (int j = 0; j < 4; ++j) { const f32x4 g = wr4[64 * j]; u32x2 o; o.x = cvt_pk_bf16(v[j].x * rstd * g.x, v[j].y * rstd * g.y); o.y = cvt_pk_bf16(v[j].z * rstd * g.z, v[j].w * rstd * g.w); o8[64 * j] = o; }
}

__device__ __forceinline__ unsigned off_b(unsigned row, unsigned ch) { return 256u * row + 16u * (ch ^ (((row & 3) << 2) | ((row >> 2) & 3))); }
__device__ __forceinline__ void load_tile128(LAS unsigned char* img, const bf16_t* g, size_t pitch, int tid, int zrows) {
#pragma unroll
    for (int i = 0; i < 4; ++i) { const int n = tid + 512 * i, row = n >> 4, ch = n & 15;
        u32x4 v = (u32x4){0u, 0u, 0u, 0u};
        if (row >= zrows) v = *(const u32x4*)(g + (size_t)(row - zrows) * pitch + ch * 8);
        *(LAS u32x4*)(img + off_b(row, ch)) = v; }
}
__device__ __forceinline__ bf16x8 tr_read2(unsigned a0, unsigned a1) {
    s16x4 r0, r1;
    asm volatile("ds_read_b64_tr_b16 %0, %2\n\tds_read_b64_tr_b16 %1, %3\n\ts_waitcnt lgkmcnt(0)" : "=&v"(r0), "=&v"(r1) : "v"(a0), "v"(a1) : "memory");
    bf16x8 o; o[0] = r0[0]; o[1] = r0[1]; o[2] = r0[2]; o[3] = r0[3]; o[4] = r1[0]; o[5] = r1[1]; o[6] = r1[2]; o[7] = r1[3]; return o;
}

__device__ __forceinline__ bf16x8 cat4(const s16x4 r0, const s16x4 r1) { bf16x8 o; o[0] = r0[0]; o[1] = r0[1]; o[2] = r0[2]; o[3] = r0[3]; o[4] = r1[0]; o[5] = r1[1]; o[6] = r1[2]; o[7] = r1[3]; return o; }
__device__ __forceinline__ void tr_read8(unsigned a0, unsigned a1, bf16x8 (&f)[4]) {
    s16x4 r0, r1, r2, r3, r4, r5, r6, r7;
    asm volatile("ds_read_b64_tr_b16 %0, %8\n\tds_read_b64_tr_b16 %1, %9\n\tds_read_b64_tr_b16 %2, %8 offset:8192\n\tds_read_b64_tr_b16 %3, %9 offset:8192\n\t"
                 "ds_read_b64_tr_b16 %4, %8 offset:16384\n\tds_read_b64_tr_b16 %5, %9 offset:16384\n\tds_read_b64_tr_b16 %6, %8 offset:24576\n\tds_read_b64_tr_b16 %7, %9 offset:24576\n\ts_waitcnt lgkmcnt(0)"
                 : "=&v"(r0), "=&v"(r1), "=&v"(r2), "=&v"(r3), "=&v"(r4), "=&v"(r5), "=&v"(r6), "=&v"(r7) : "v"(a0), "v"(a1) : "memory");
    f[0] = cat4(r0, r1); f[1] = cat4(r2, r3); f[2] = cat4(r4, r5); f[3] = cat4(r6, r7);
}
__device__ __forceinline__ void tr_read4x2(unsigned a0, unsigned a1, unsigned a2, unsigned a3, bf16x8 (&f)[4]) {
    s16x4 r0, r1, r2, r3, r4, r5, r6, r7;
    asm volatile("ds_read_b64_tr_b16 %0, %8\n\tds_read_b64_tr_b16 %1, %8 offset:4096\n\tds_read_b64_tr_b16 %2, %9\n\tds_read_b64_tr_b16 %3, %9 offset:4096\n\t"
                 "ds_read_b64_tr_b16 %4, %10\n\tds_read_b64_tr_b16 %5, %10 offset:4096\n\tds_read_b64_tr_b16 %6, %11\n\tds_read_b64_tr_b16 %7, %11 offset:4096\n\ts_waitcnt lgkmcnt(0)"
                 : "=&v"(r0), "=&v"(r1), "=&v"(r2), "=&v"(r3), "=&v"(r4), "=&v"(r5), "=&v"(r6), "=&v"(r7) : "v"(a0), "v"(a1), "v"(a2), "v"(a3) : "memory");
    f[0] = cat4(r0, r1); f[1] = cat4(r2, r3); f[2] = cat4(r4, r5); f[3] = cat4(r6, r7);
}

__device__ __forceinline__ void kv_compute(LAS unsigned char* lds, float* dst, float scale, int w, int lane) {
    const unsigned bK = (unsigned)(uintptr_t)lds, bV = bK + 32768u;
    const unsigned g = lane >> 4, q = (lane & 15) >> 2, p = lane & 3;
    bf16x8 Kf[4];
    tr_read8(bK + off_b(8 * g + q, 2 * w + (p >> 1)) + 8 * (p & 1), bK + off_b(8 * g + 4 + q, 2 * w + (p >> 1)) + 8 * (p & 1), Kf);
#pragma unroll
    for (int et = 0; et < 8; ++et) {
        f32x4 acc = (f32x4){0.f, 0.f, 0.f, 0.f};
        bf16x8 Vf[4];
        tr_read8(bV + off_b(8 * g + q, 2 * et + (p >> 1)) + 8 * (p & 1), bV + off_b(8 * g + 4 + q, 2 * et + (p >> 1)) + 8 * (p & 1), Vf);
#pragma unroll
        for (int ks = 0; ks < 4; ++ks) acc = __builtin_amdgcn_mfma_f32_16x16x32_bf16(Vf[ks], Kf[ks], acc, 0, 0, 0);
        *(f32x4*)(dst + (size_t)(16 * w + (lane & 15)) * 128 + 16 * et + 4 * g) = acc * scale;
    }
}

__device__ __forceinline__ void ln8_stats(const float (&y)[8], float (&mu)[8], float (&rs)[8], LAS f32x2* red, int w, int lane) {
#pragma unroll
    for (int t = 0; t < 8; ++t) { const float s = wave_sum(y[t]), qq = wave_sum(y[t] * y[t]); if (lane == 0) red[w * 8 + t] = (f32x2){s, qq}; }
    __syncthreads();
#pragma unroll
    for (int t = 0; t < 8; ++t) { float s = 0.f, qq = 0.f;
#pragma unroll
        for (int ww = 0; ww < 8; ++ww) { const f32x2 v = red[ww * 8 + t]; s += v.x; qq += v.y; }
        const float m = s * (1.f / CC); float var = qq * (1.f / CC) - m * m; var = var < 0.f ? 0.f : var; mu[t] = m; rs[t] = 1.0f / sqrtf(var + EPS); }
    __syncthreads();
}


#define XB_TMO      128
#define XB_XCNT(j)  (256  + 64 * (j))
#define XB_XSUB(j)  (1280 + 64 * (j))
#define XB_XGEN(j)  (2304 + 64 * (j))
#define XB_TOP      3328
#define XB_TOPGEN   3392
#define XCD_BAR_WORDS 3456
#define XB_SPIN_CAP (1u << 22)
__device__ __forceinline__ unsigned xb_ld(unsigned* p)              { return __hip_atomic_load(p, __ATOMIC_RELAXED, __HIP_MEMORY_SCOPE_AGENT); }
__device__ __forceinline__ unsigned xb_add(unsigned* p, unsigned v) { return __hip_atomic_fetch_add(p, v, __ATOMIC_RELAXED, __HIP_MEMORY_SCOPE_AGENT); }
__device__ __forceinline__ unsigned xb_xcc_id() { return (unsigned)__builtin_amdgcn_s_getreg((3 << 11) | 20) & 0xFu; }
#define XB_SPIN(cond, bar) do { unsigned _sp = 0; while (cond) { __builtin_amdgcn_s_sleep(1); \
    if ((++_sp & 255u) == 0u) { if (xb_ld(&(bar)[XB_TMO])) break; if (_sp > XB_SPIN_CAP) { atomicAdd(&(bar)[XB_TMO], 1u); break; } } } } while (0)
struct XcdBarrier { unsigned* bar; unsigned x; volatile LAS unsigned* st; };
__device__ __forceinline__ XcdBarrier xcd_barrier_post(unsigned* bar, volatile LAS unsigned* st) {
    XcdBarrier b; b.bar = bar; b.x = xb_xcc_id(); b.st = st;
    if (threadIdx.x == 0) (void)xb_add(&bar[XB_XCNT(b.x)], 1u);
    return b;
}
__device__ __forceinline__ void xcd_barrier_complete(unsigned* bar, unsigned x, unsigned& nloc, unsigned& nx) {
    const unsigned G = gridDim.x * gridDim.y * gridDim.z;
    unsigned sum, cnt, mine, sp = 0u;
    for (;;) {
        sum = 0u; cnt = 0u; mine = 0u;
#pragma unroll
        for (unsigned j = 0; j < 16; ++j) { const unsigned c = xb_ld(&bar[XB_XCNT(j)]); sum += c; cnt += (c > 0u) ? 1u : 0u; mine = (j == x) ? c : mine; }
        if (sum == G) break;
        __builtin_amdgcn_s_sleep(1);
        if ((++sp & 255u) == 0u) { if (xb_ld(&bar[XB_TMO])) break; if (sp > XB_SPIN_CAP) { atomicAdd(&bar[XB_TMO], 1u); break; } }
    }
    nloc = mine > 0u ? mine : 1u; nx = cnt > 0u ? cnt : 1u;
}
__device__ __forceinline__ void xcd_barrier(const XcdBarrier& b) {
    asm volatile("s_waitcnt vmcnt(0)" ::: "memory");
    __syncthreads();
    if (threadIdx.x == 0) {
        unsigned* bar = b.bar;
        __builtin_amdgcn_s_waitcnt(0);
        unsigned nloc = b.st[0], nx = b.st[1];
        if (nloc == 0u) { xcd_barrier_complete(bar, b.x, nloc, nx); b.st[0] = nloc; b.st[1] = nx; }
        const unsigned old = xb_add(&bar[XB_XSUB(b.x)], 1u);
        const unsigned gen = old / nloc;
        if (old + 1u == (gen + 1u) * nloc) {
            __builtin_amdgcn_fence(__ATOMIC_RELEASE, "agent");
            asm volatile("s_waitcnt vmcnt(0)" ::: "memory");
            const unsigned og = xb_add(&bar[XB_TOP], 1u);
            const unsigned tg = og / nx;
            if (og + 1u == (tg + 1u) * nx) xb_add(&bar[XB_TOPGEN], 1u);
            else XB_SPIN(xb_ld(&bar[XB_TOPGEN]) == tg, bar);
            __builtin_amdgcn_fence(__ATOMIC_ACQUIRE, "agent");
            xb_add(&bar[XB_XGEN(b.x)], 1u);
            asm volatile("s_waitcnt vmcnt(0)" ::: "memory");
        } else {
            XB_SPIN(xb_ld(&bar[XB_XGEN(b.x)]) == gen, bar);
            __builtin_amdgcn_fence(__ATOMIC_ACQUIRE, "agent");
            asm volatile("s_waitcnt vmcnt(0)" ::: "memory");
        }
    }
    __syncthreads();
}
#ifndef REP_MASK
#define REP_MASK 0
#endif
#ifndef EXTRA_SYNCS
#define EXTRA_SYNCS 0
#endif
#define REP_BEGIN(k) { int nrep_ = 1 + ((REP_MASK >> (k)) & 1); asm volatile("" : "+s"(nrep_)); for (int rep_ = 0; rep_ < nrep_; ++rep_) { if (rep_) GRID_SYNC();
#define REP_END } }
struct Args { const float* in[17]; float* out; unsigned char* ws; };

__global__ void __launch_bounds__(512, 2) mk_fwd(Args a) {
    extern __shared__ __attribute__((aligned(16))) unsigned char lds_raw[];
    LAS unsigned char* lds = (LAS unsigned char*)lds_raw;
    cg::grid_group grid = cg::this_grid();
    if (a.ws == nullptr) grid.sync();
    volatile LAS unsigned* bst = (volatile LAS unsigned*)(lds + 131072 + 64);
    if (threadIdx.x < 2) bst[threadIdx.x] = 0u;
    __syncthreads();
    const XcdBarrier xbar = xcd_barrier_post((unsigned*)(a.ws + WS_CTL), bst);
#define GRID_SYNC() xcd_barrier(xbar)
#define PHASE_IDS int tid = threadIdx.x; asm volatile("" : "+v"(tid)); const int lane = tid & 63, w = __builtin_amdgcn_readfirstlane(tid >> 6); (void)lane; (void)w;
    const int G = gridDim.x, bx = blockIdx.x;
    unsigned char* ws = a.ws; float* out = a.out;
    const float* x_prompt = a.in[0]; const float* x_sample = a.in[1]; const float* state_ret = a.in[2]; const float* state_conv = a.in[3]; const float* meta = a.in[4];
    const float* g_mix_pre = a.in[5]; const float* g_mix_post = a.in[6]; const float* g_ffn_pre = a.in[7]; const float* g_ffn_post = a.in[8];
    const float* w_in = a.in[9]; const float* conv_w = a.in[10]; const float* conv_b = a.in[11]; const float* ln_g = a.in[12]; const float* ln_b = a.in[13];
    const float* w_out = a.in[14]; const float* w_ffn_in = a.in[15]; const float* w_ffn_out = a.in[16];
    f32x2* ROPE = (f32x2*)(ws + WS_ROPE);
    bf16_t* W1T = (bf16_t*)(ws + WS_W1T); bf16_t* WOT = (bf16_t*)(ws + WS_WOT); bf16_t* W3T = (bf16_t*)(ws + WS_W3T); bf16_t* W4T = (bf16_t*)(ws + WS_W4T);
    bf16_t* XN = (bf16_t*)(ws + WS_XN);
    bf16_t* Qb = (bf16_t*)(ws + WS_Q); bf16_t* Kb = (bf16_t*)(ws + WS_K); bf16_t* Vb = (bf16_t*)(ws + WS_V); bf16_t* SGb = (bf16_t*)(ws + WS_SG); bf16_t* Ub = (bf16_t*)(ws + WS_U);
    bf16_t* MIXIN = (bf16_t*)(ws + WS_MIXIN); float* KV = (float*)(ws + WS_KV); bf16_t* RP = (bf16_t*)(ws + WS_RP); bf16_t* MIX = (bf16_t*)(ws + WS_MIX);
    float* RS2 = (float*)(ws + WS_RS2);
    bf16_t* ACT = (bf16_t*)(ws + WS_ACT); bf16_t* FFN = (bf16_t*)(ws + WS_FFN);

    REP_BEGIN(0) {
        PHASE_IDS
        LAS float* scr = (LAS float*)(lds + w * 16384);
        const int gw = bx * 8 + w, NGW = G * 8;
        constexpr int I1 = (D / 64) * (INC / 32), IO = (D / 64) * (D / 32), I3 = (D / 64) * (2 * FF / 32), I4 = (FF / 64) * (D / 32);
        for (int it = gw; it < I1 + IO + I3 + I4; it += NGW) {
            int r = it;
            if (r < I1) { p0_transpose_item<1>(w_in, D, INC, W1T, scr, r, lane); continue; } r -= I1;
            if (r < IO) { p0_transpose_item<0>(w_out, D, D, WOT, scr, r, lane); continue; } r -= IO;
            if (r < I3) { p0_transpose_item<2>(w_ffn_in, D, 2 * FF, W3T, scr, r, lane, g_ffn_pre); continue; } r -= I3;
            p0_transpose_item<0>(w_ffn_out, FF, D, W4T, scr, r, lane);
        }
        for (int m0 = 2 * gw; m0 < ROW_E; m0 += 2 * NGW) {
            const float* s0p = m0 < ROW_S ? x_prompt + (size_t)m0 * D : m0 < ROW_M ? x_sample + (size_t)(m0 - ROW_S) * D : meta + (size_t)(m0 - ROW_M) * D;
            const int m1 = m0 + 1;
            const float* s1p = m1 < ROW_S ? x_prompt + (size_t)m1 * D : m1 < ROW_M ? x_sample + (size_t)(m1 - ROW_S) * D : meta + (size_t)(m1 - ROW_M) * D;
            const f32x4* xa = (const f32x4*)s0p + lane; const f32x4* xb = (const f32x4*)s1p + lane; const f32x4* wr4 = (const f32x4*)g_mix_pre + lane;
            f32x4 va[4], vb[4]; float sa = 0.f, sb = 0.f;
#pragma unroll
            for (int j = 0; j < 4; ++j) { va[j] = xa[64 * j]; vb[j] = xb[64 * j]; }
#pragma unroll
            for (int j = 0; j < 4; ++j) { sa += (va[j].x * va[j].x + va[j].y * va[j].y) + (va[j].z * va[j].z + va[j].w * va[j].w); sb += (vb[j].x * vb[j].x + vb[j].y * vb[j].y) + (vb[j].z * vb[j].z + vb[j].w * vb[j].w); }
#pragma unroll
            for (int o = 1; o < 64; o <<= 1) { const float ta = __shfl_xor(sa, o), tb = __shfl_xor(sb, o); sa += ta; sb += tb; }
            const float ra = 1.0f / sqrtf(sa * (1.f / D) + EPS), rb = 1.0f / sqrtf(sb * (1.f / D) + EPS);
            u32x2* oa = (u32x2*)(XN + (size_t)m0 * D) + lane; u32x2* ob = (u32x2*)(XN + (size_t)m1 * D) + lane;
#pragma unroll
            for (int j = 0; j < 4; ++j) { const f32x4 g = wr4[64 * j]; u32x2 o;
                o.x = cvt_pk_bf16(va[j].x * ra * g.x, va[j].y * ra * g.y); o.y = cvt_pk_bf16(va[j].z * ra * g.z, va[j].w * ra * g.w); oa[64 * j] = o;
                o.x = cvt_pk_bf16(vb[j].x * rb * g.x, vb[j].y * rb * g.y); o.y = cvt_pk_bf16(vb[j].z * rb * g.z, vb[j].w * rb * g.w); ob[64 * j] = o; }
        }
        for (int idx = bx * 512 + tid; idx < 2065 * 64; idx += G * 512) {
            const int pi = idx >> 6, j = idx & 63;
            const float posf = pi == 2064 ? 16384.f : (float)pi;
            const float lin = (float)j / 63.0f;
            const float pw = (float)exp2((double)lin * 13.287712379549449);
            const float inv = 1.0f / pw;
            float s, c; sincos_acc(posf * inv, s, c);
            ROPE[idx] = (f32x2){c, s};
        }
    } REP_END
    GRID_SYNC();

    for (int es_ = 0; es_ < EXTRA_SYNCS; ++es_) GRID_SYNC();
    REP_BEGIN(1) {
        pg8::Gemm g{XN, W1T, ROW_S, INC, D}; pg8::StaticOrder S; S.init(ROW_S, INC, G, bx);
        EpiProj E{Qb, Kb, Vb, SGb, Ub, ROPE, out};
        pg8::gemm_phase<EpiProj>(lds, g, S, E);
        skinny_phase<EpiProj, D>(lds, XN, W1T, INC / 256, 9, ROW_S, E, bx, G);
    } REP_END
    GRID_SYNC();

    REP_BEGIN(2) {
        PHASE_IDS
        constexpr int N_KV = 512, N_KVM = 4, N_SR = NS * NH, N_CP = ROW_S / 32, N_CS = NS;
        constexpr int I_KVM = N_KV, I_SR = I_KVM + N_KVM, I_CP = I_SR + N_SR, I_CS = I_CP + N_CP, I_END = I_CS + N_CS;
        for (int it = bx; it < I_SR; it += G) {
            {
                const bool ismeta = it >= I_KVM;
                const int h = ismeta ? it - I_KVM : (it >> 4) & 3;
                const int row0 = ismeta ? ROW_M : (it >> 6) * SEQ + (it & 15) * 128;
                __syncthreads();
                load_tile128(lds, Kb + (size_t)row0 * 512 + h * 128, 512, tid, ismeta ? 112 : 0);
                load_tile128(lds + 32768, Vb + (size_t)row0 * 512 + h * 128, 512, tid, ismeta ? 112 : 0);
                __syncthreads();
                kv_compute(lds, KV + (size_t)it * 16384, exp2f(lg2gamma(h) * 127.f), w, lane);
            }
        }
        for (int it = I_SR + bx; it < I_CP; it += G) {
            {
                const int sr = it - I_SR, i = sr >> 2, h = sr & 3, r = ROW_S + i;
                const int e4 = tid & 31, dg = tid >> 5;
                const float gam = exp2f(lg2gamma(h));
                const float* S0 = state_ret + (size_t)sr * 16384; float* S1 = out + OFF_RETS + (size_t)sr * 16384;
                const u32x2 vv = *(const u32x2*)(Vb + (size_t)r * 512 + h * 128 + 4 * e4);
                const f32x4 v4 = (f32x4){bflo(vv.x), bfhi(vv.x), bflo(vv.y), bfhi(vv.y)};
                f32x4 oacc = (f32x4){0.f, 0.f, 0.f, 0.f};
#pragma unroll
                for (int ii = 0; ii < 8; ++ii) { const int d = dg + 16 * ii;
                    const float kd = bf2f(Kb[(size_t)r * 512 + h * 128 + d]), qd = bf2f(Qb[(size_t)r * 512 + h * 128 + d]);
                    f32x4 s = *(const f32x4*)(S0 + d * 128 + 4 * e4);
                    s = s * gam + v4 * kd;
                    *(f32x4*)(S1 + d * 128 + 4 * e4) = s;
                    oacc += s * qd; }
                LAS float* red = (LAS float*)lds;
                __syncthreads();
                *(LAS f32x4*)(red + dg * 128 + 4 * e4) = oacc;
                __syncthreads();
                if (tid < 128) { float o = 0.f;
#pragma unroll
                    for (int k = 0; k < 16; ++k) o += red[k * 128 + tid];
                    const float ss = wave_sum(o * o);
                    if (lane == 0) red[2048 + w] = ss;
                    red[2304 + tid] = o; }
                __syncthreads();
                if (tid < 128) { const float ss = red[2048] + red[2049]; const float o = red[2304 + tid] * (1.0f / sqrtf(ss * (1.f / HD) + EPS));
                    const float sg = bf2f(SGb[(size_t)r * 512 + h * 128 + tid]);
                    MIXIN[(size_t)r * 1024 + h * 128 + tid] = (bf16_t)(cvt_pk_bf16(o * sg, 0.f) & 0xffffu); }
            }
        }
        for (int it = I_CP + bx; it < I_CS; it += G) {
            {
                const int ct = it - I_CP, b = ct >> 6, s0 = (ct & 63) * 32;
                LAS bf16_t* ub = (LAS bf16_t*)lds;
                LAS float* ybuf = (LAS float*)(lds + 65536);
                LAS f32x2* stats = (LAS f32x2*)(lds + 131072 + 256);
                const int cp = tid & 255, th = tid >> 8;
                __syncthreads();
#pragma unroll
                for (int i8 = 0; i8 < 8; ++i8) { const int n = tid + 512 * i8; const int rho = n >> 6, ch = n & 63; const int P = 16 + s0 - 30 + rho;
                    u32x4 v = (u32x4){0u, 0u, 0u, 0u};
                    if (n < 62 * 64) {
                        if (P >= 0) { const int row = P < 16 ? ROW_M + P : b * SEQ + P - 16; v = *(const u32x4*)(Ub + (size_t)row * 512 + ch * 8); }
                        *(LAS u32x4*)(ub + rho * 512 + ch * 8) = v; } }
                f32x2 wj[31];
#pragma unroll
                for (int j = 0; j < 31; ++j) wj[j] = *(const f32x2*)(conv_w + j * 512 + 2 * cp);
                const f32x2 cb = *(const f32x2*)(conv_b + 2 * cp), lg = *(const f32x2*)(ln_g + 2 * cp), lb = *(const f32x2*)(ln_b + 2 * cp);
                __syncthreads();
                {
                    f32x2 acc[16];
#pragma unroll
                    for (int t = 0; t < 16; ++t) acc[t] = cb;
#pragma unroll
                    for (int k = 0; k < 46; ++k) { const unsigned uw = *(const LAS unsigned*)(ub + (th * 16 + k) * 512 + 2 * cp); const f32x2 v = (f32x2){bflo(uw), bfhi(uw)};
#pragma unroll
                        for (int t = 0; t < 16; ++t) if (k - t >= 0 && k - t <= 30) acc[t] = __builtin_elementwise_fma(wj[k - t], v, acc[t]); }
#pragma unroll
                    for (int t = 0; t < 16; ++t) *(LAS f32x2*)(ybuf + (th * 16 + t) * 512 + 2 * cp) = acc[t];
                }
                __syncthreads();
                { float sv[4], qv[4];
#pragma unroll
                  for (int i = 0; i < 4; ++i) { float s = 0.f, q = 0.f;
#pragma unroll
                      for (int k = 0; k < 8; ++k) { const float v = ybuf[(4 * w + i) * 512 + lane + 64 * k]; s += v; q += v * v; }
                      sv[i] = s; qv[i] = q; }
#pragma unroll
                  for (int o = 1; o < 64; o <<= 1) {
                      float a[4], c[4];
#pragma unroll
                      for (int i = 0; i < 4; ++i) { a[i] = __shfl_xor(sv[i], o); c[i] = __shfl_xor(qv[i], o); }
#pragma unroll
                      for (int i = 0; i < 4; ++i) { sv[i] += a[i]; qv[i] += c[i]; } }
                  if (lane == 0) {
#pragma unroll
                      for (int i = 0; i < 4; ++i) { const float m = sv[i] * (1.f / CC); float var = qv[i] * (1.f / CC) - m * m; var = var < 0.f ? 0.f : var; stats[4 * w + i] = (f32x2){m, 1.0f / sqrtf(var + EPS)}; } } }
                __syncthreads();
#pragma unroll
                for (int t = 0; t < 16; ++t) { const f32x2 st = stats[th * 16 + t]; const f32x2 yv = *(const LAS f32x2*)(ybuf + (th * 16 + t) * 512 + 2 * cp); const f32x2 yn = (yv - st.x) * st.y * lg + lb; const int row = b * SEQ + s0 + th * 16 + t;
                    *(unsigned*)(MIXIN + (size_t)row * 1024 + 512 + 2 * cp) = cvt_pk_bf16(silu_f(yn.x), silu_f(yn.y)); }
            }
        }
        for (int it = I_CS + bx; it < I_END; it += G) {
            {
                const int i = it - I_CS;
                LAS f32x2* red = (LAS f32x2*)(lds + 65536);
                float wj[31];
#pragma unroll
                for (int j = 0; j < 31; ++j) wj[j] = conv_w[j * 512 + tid];
                const float cb = conv_b[tid], lg = ln_g[tid], lb = ln_b[tid];
                float acc = cb;
                const float* bufp = state_conv + (size_t)i * 30 * 512 + tid; float* op = out + OFF_CONVS + (size_t)i * 30 * 512 + tid;
#pragma unroll
                for (int j = 0; j < 30; ++j) { const float bv = bufp[j * 512]; acc += wj[j] * bv; if (j >= 1) op[(j - 1) * 512] = bv; }
                acc += wj[30] * bf2f(Ub[(size_t)(ROW_S + i) * 512 + tid]);
                float s = acc, q = acc * acc;
#pragma unroll
                for (int o = 1; o < 64; o <<= 1) { const float a0 = __shfl_xor(s, o), a1 = __shfl_xor(q, o); s += a0; q += a1; }
                __syncthreads();
                if (lane == 0) red[w] = (f32x2){s, q};
                __syncthreads();
                float ts = 0.f, tq = 0.f;
#pragma unroll
                for (int ww = 0; ww < 8; ++ww) { const f32x2 v = red[ww]; ts += v.x; tq += v.y; }
                const float m = ts * (1.f / CC); float var = tq * (1.f / CC) - m * m; var = var < 0.f ? 0.f : var;
                const float yn = (acc - m) * (1.0f / sqrtf(var + EPS)) * lg + lb;
                MIXIN[(size_t)(ROW_S + i) * 1024 + 512 + tid] = (bf16_t)(cvt_pk_bf16(silu_f(yn), 0.f) & 0xffffu);
            }
        }
    } REP_END
    GRID_SYNC();

    REP_BEGIN(3) {
        PHASE_IDS
        for (int idx = bx * 512 + tid; idx < 32 * 4096; idx += G * 512) {
            const int bh = idx >> 12, rem = idx & 4095, h = bh & 3;
            const float lg2 = lg2gamma(h), gam = exp2f(lg2), Gam = exp2f(lg2 * 128.f);
            f32x4 R = *(const f32x4*)(KV + (size_t)(512 + h) * 16384 + rem * 4);
            for (int c = 0; c < 16; ++c) {
                const f32x4 rs = R * gam; u32x2 o; o.x = cvt_pk_bf16(rs[0], rs[1]); o.y = cvt_pk_bf16(rs[2], rs[3]);
                *(u32x2*)(RP + (size_t)(bh * 16 + c) * 16384 + rem * 4) = o;
                R = R * Gam + *(const f32x4*)(KV + (size_t)(bh * 16 + c) * 16384 + rem * 4);
            }
            *(f32x4*)(out + OFF_RETP + (size_t)bh * 16384 + rem * 4) = R;
        }
    } REP_END
    GRID_SYNC();

    REP_BEGIN(4) {
        PHASE_IDS
        const unsigned bQ = (unsigned)(uintptr_t)lds, bKi = bQ + 32768u, bV = bQ + 65536u, bR = bQ + 98304u;
        const unsigned g = lane >> 4, q = (lane & 15) >> 2, p = lane & 3, fr = lane & 15;
        for (int it = bx; it < 512; it += G) {
            const int b = it >> 6, h = (it >> 4) & 3, c = it & 15;
            const int row0 = b * SEQ + c * 128;
            __syncthreads();
            load_tile128(lds, Qb + (size_t)row0 * 512 + h * 128, 512, tid, 0);
            load_tile128(lds + 32768, Kb + (size_t)row0 * 512 + h * 128, 512, tid, 0);
            load_tile128(lds + 65536, Vb + (size_t)row0 * 512 + h * 128, 512, tid, 0);
            load_tile128(lds + 98304, RP + (size_t)it * 16384, 128, tid, 0);
            __syncthreads();
            bf16x8 Qf[4];
#pragma unroll
            for (int s = 0; s < 4; ++s) Qf[s] = *(const LAS bf16x8*)(lds + off_b(fr + 16 * w, 4 * s + g));
            f32x4 accO[8];
#pragma unroll
            for (int et = 0; et < 8; ++et) {
                f32x4 acc = (f32x4){0.f, 0.f, 0.f, 0.f};
                bf16x8 Rf[4];
                tr_read8(bR + off_b(8 * g + q, 2 * et + (p >> 1)) + 8 * (p & 1), bR + off_b(8 * g + 4 + q, 2 * et + (p >> 1)) + 8 * (p & 1), Rf);
#pragma unroll
                for (int ks = 0; ks < 4; ++ks) acc = __builtin_amdgcn_mfma_f32_16x16x32_bf16(Rf[ks], Qf[ks], acc, 0, 0, 0);
                accO[et] = acc;
            }
            for (int jp = 0; 2 * jp <= w; ++jp) {
                const int ja = 2 * jp, jb = 2 * jp + 1;
                f32x4 sa = (f32x4){0.f, 0.f, 0.f, 0.f}, sb = (f32x4){0.f, 0.f, 0.f, 0.f};
#pragma unroll
                for (int s = 0; s < 4; ++s) { const bf16x8 Kf = *(const LAS bf16x8*)(lds + 32768 + off_b(fr + 16 * ja, 4 * s + g)); sa = __builtin_amdgcn_mfma_f32_16x16x32_bf16(Kf, Qf[s], sa, 0, 0, 0); }
                if (jb <= w) {
#pragma unroll
                    for (int s = 0; s < 4; ++s) { const bf16x8 Kf = *(const LAS bf16x8*)(lds + 32768 + off_b(fr + 16 * jb, 4 * s + g)); sb = __builtin_amdgcn_mfma_f32_16x16x32_bf16(Kf, Qf[s], sb, 0, 0, 0); }
                }
                if (ja == w) {
#pragma unroll
                    for (int rg = 0; rg < 4; ++rg) if (4 * g + rg > fr) sa[rg] = 0.f; }
                if (jb == w) {
#pragma unroll
                    for (int rg = 0; rg < 4; ++rg) if (4 * g + rg > fr) sb[rg] = 0.f; }
                bf16x8 Pf;
                { const unsigned p0 = cvt_pk_bf16(sa[0], sa[1]), p1 = cvt_pk_bf16(sa[2], sa[3]), p2 = cvt_pk_bf16(sb[0], sb[1]), p3 = cvt_pk_bf16(sb[2], sb[3]);
                  Pf[0] = (short)(p0 & 0xffff); Pf[1] = (short)(p0 >> 16); Pf[2] = (short)(p1 & 0xffff); Pf[3] = (short)(p1 >> 16);
                  Pf[4] = (short)(p2 & 0xffff); Pf[5] = (short)(p2 >> 16); Pf[6] = (short)(p3 & 0xffff); Pf[7] = (short)(p3 >> 16); }
#pragma unroll
                for (int eg = 0; eg < 2; ++eg) {
                    bf16x8 Vf[4];
                    tr_read4x2(bV + off_b(32 * jp + 4 * g + q, 2 * (4 * eg + 0) + (p >> 1)) + 8 * (p & 1), bV + off_b(32 * jp + 4 * g + q, 2 * (4 * eg + 1) + (p >> 1)) + 8 * (p & 1),
                               bV + off_b(32 * jp + 4 * g + q, 2 * (4 * eg + 2) + (p >> 1)) + 8 * (p & 1), bV + off_b(32 * jp + 4 * g + q, 2 * (4 * eg + 3) + (p >> 1)) + 8 * (p & 1), Vf);
#pragma unroll
                    for (int e2 = 0; e2 < 4; ++e2) accO[4 * eg + e2] = __builtin_amdgcn_mfma_f32_16x16x32_bf16(Vf[e2], Pf, accO[4 * eg + e2], 0, 0, 0);
                }
            }
            float ss = 0.f;
#pragma unroll
            for (int et = 0; et < 8; ++et) ss += (accO[et][0] * accO[et][0] + accO[et][1] * accO[et][1]) + (accO[et][2] * accO[et][2] + accO[et][3] * accO[et][3]);
            ss += __shfl_xor(ss, 16); ss += __shfl_xor(ss, 32);
            const float rstd = 1.0f / sqrtf(ss * (1.f / HD) + EPS);
            const int row = row0 + 16 * w + fr;
#pragma unroll
            for (int et = 0; et < 8; ++et) {
                const u32x2 sg = *(const u32x2*)(SGb + (size_t)row * 512 + h * 128 + 16 * et + 4 * g);
                u32x2 o; o.x = cvt_pk_bf16(accO[et][0] * rstd * bflo(sg.x), accO[et][1] * rstd * bfhi(sg.x)); o.y = cvt_pk_bf16(accO[et][2] * rstd * bflo(sg.y), accO[et][3] * rstd * bfhi(sg.y));
                *(u32x2*)(MIXIN + (size_t)row * 1024 + h * 128 + 16 * et + 4 * g) = o;
            }
        }
        __syncthreads();
    } REP_END
    GRID_SYNC();

    REP_BEGIN(5) {
        pg8::Gemm g{MIXIN, WOT, ROW_S, D, D}; pg8::StaticOrder S; S.init(ROW_S, D, G, bx);
        EpiPlain E{MIX, D};
        pg8::gemm_phase<EpiPlain>(lds, g, S, E);
        skinny_phase<EpiPlain, D>(lds, MIXIN, WOT, D / 256, 8, ROW_S, E, bx, G);
    } REP_END
    GRID_SYNC();

    REP_BEGIN(6) {
        PHASE_IDS
        const int gw = bx * 8 + w, NGW = G * 8;
        for (int m0 = 2 * gw; m0 < ROW_M; m0 += 2 * NGW) {
            f32x4 xv[2][4]; u32x2 mt[2][4];
#pragma unroll
            for (int rr = 0; rr < 2; ++rr) { const int m = m0 + rr;
                const float* hrow = m < ROW_S ? x_prompt + (size_t)m * D : x_sample + (size_t)(m - ROW_S) * D;
                const f32x4* xr = (const f32x4*)hrow + lane; const u32x2* mr = (const u32x2*)(MIX + (size_t)m * D) + lane;
#pragma unroll
                for (int j = 0; j < 4; ++j) { xv[rr][j] = xr[64 * j]; mt[rr][j] = mr[64 * j]; } }
            f32x4 mv[2][4]; float s[2] = {0.f, 0.f};
#pragma unroll
            for (int rr = 0; rr < 2; ++rr)
#pragma unroll
                for (int j = 0; j < 4; ++j) { const u32x2 t = mt[rr][j]; mv[rr][j] = (f32x4){bflo(t.x), bfhi(t.x), bflo(t.y), bfhi(t.y)}; s[rr] += (mv[rr][j].x * mv[rr][j].x + mv[rr][j].y * mv[rr][j].y) + (mv[rr][j].z * mv[rr][j].z + mv[rr][j].w * mv[rr][j].w); }
#pragma unroll
            for (int o = 1; o < 64; o <<= 1) { const float ta = __shfl_xor(s[0], o), tb = __shfl_xor(s[1], o); s[0] += ta; s[1] += tb; }
            float s2[2] = {0.f, 0.f};
#pragma unroll
            for (int rr = 0; rr < 2; ++rr) { const float rstd1 = 1.0f / sqrtf(s[rr] * (1.f / D) + EPS);
                u32x2* o8 = (u32x2*)(XN + (size_t)(m0 + rr) * D) + lane;
#pragma unroll
                for (int j = 0; j < 4; ++j) { const f32x4 gp = ((const f32x4*)g_mix_post + lane)[64 * j]; const f32x4 hv = xv[rr][j] + mv[rr][j] * rstd1 * gp;
                    s2[rr] += (hv.x * hv.x + hv.y * hv.y) + (hv.z * hv.z + hv.w * hv.w);
                    u32x2 o; o.x = cvt_pk_bf16(hv.x, hv.y); o.y = cvt_pk_bf16(hv.z, hv.w); o8[64 * j] = o; } }
#pragma unroll
            for (int o = 1; o < 64; o <<= 1) { const float ta = __shfl_xor(s2[0], o), tb = __shfl_xor(s2[1], o); s2[0] += ta; s2[1] += tb; }
            if (lane == 0) { RS2[m0] = 1.0f / sqrtf(s2[0] * (1.f / D) + EPS); RS2[m0 + 1] = 1.0f / sqrtf(s2[1] * (1.f / D) + EPS); }
        }
    } REP_END
    GRID_SYNC();

    REP_BEGIN(7) {
        pg8::Gemm g{XN, W3T, ROW_S, 2 * FF, D}; pg8::StaticOrder S; S.init(ROW_S, 2 * FF, G, bx);
        EpiGlu E{ACT, RS2};
        pg8::gemm_phase<EpiGlu>(lds, g, S, E);
        if (bx >= G / 2) skinny_phase<EpiGlu, D>(lds, XN, W3T, 2 * FF / 256, 8, ROW_S, E, bx - G / 2, G / 2);
    } REP_END
    GRID_SYNC();

    REP_BEGIN(8) {
        pg8::Gemm g{ACT, W4T, ROW_S, D, FF}; pg8::StaticOrder S; S.init(ROW_S, D, G, bx);
        EpiPlain E{FFN, D};
        pg8::gemm_phase<EpiPlain>(lds, g, S, E);
        skinny_phase<EpiPlain, FF>(lds, ACT, W4T, D / 256, 8, ROW_S, E, bx, G);
    } REP_END
    GRID_SYNC();

    REP_BEGIN(9) {
        PHASE_IDS
        const int gw = bx * 8 + w, NGW = G * 8;
        for (int m0 = 2 * gw; m0 < ROW_M; m0 += 2 * NGW) {
            u32x2 ft[2][4], ht[2][4];
#pragma unroll
            for (int rr = 0; rr < 2; ++rr) { const u32x2* fr2 = (const u32x2*)(FFN + (size_t)(m0 + rr) * D) + lane; const u32x2* hr = (const u32x2*)(XN + (size_t)(m0 + rr) * D) + lane;
#pragma unroll
                for (int j = 0; j < 4; ++j) { ft[rr][j] = fr2[64 * j]; ht[rr][j] = hr[64 * j]; } }
            f32x4 fv[2][4]; float s[2] = {0.f, 0.f};
#pragma unroll
            for (int rr = 0; rr < 2; ++rr)
#pragma unroll
                for (int j = 0; j < 4; ++j) { const u32x2 t = ft[rr][j]; fv[rr][j] = (f32x4){bflo(t.x), bfhi(t.x), bflo(t.y), bfhi(t.y)}; s[rr] += (fv[rr][j].x * fv[rr][j].x + fv[rr][j].y * fv[rr][j].y) + (fv[rr][j].z * fv[rr][j].z + fv[rr][j].w * fv[rr][j].w); }
#pragma unroll
            for (int o = 1; o < 64; o <<= 1) { const float ta = __shfl_xor(s[0], o), tb = __shfl_xor(s[1], o); s[0] += ta; s[1] += tb; }
#pragma unroll
            for (int rr = 0; rr < 2; ++rr) { const float rstd = 1.0f / sqrtf(s[rr] * (1.f / D) + EPS);
                f32x4* orow = (f32x4*)(out + (size_t)(m0 + rr) * D) + lane;
#pragma unroll
                for (int j = 0; j < 4; ++j) { const f32x4 gp = ((const f32x4*)g_ffn_post + lane)[64 * j]; const u32x2 t = ht[rr][j]; const f32x4 h1 = (f32x4){bflo(t.x), bfhi(t.x), bflo(t.y), bfhi(t.y)}; orow[64 * j] = h1 + fv[rr][j] * rstd * gp; } }
        }
    } REP_END
}

extern "C" void kernel_launch(void* const* d_in, const int* in_sizes, int n_in, void* d_out, int out_size, void* d_ws, size_t ws_size, hipStream_t stream) {
    static int grid = 0;
    if (grid == 0) {
        int dev = 0, cus = 0, per_cu = 0;
        hipGetDevice(&dev);
        hipDeviceGetAttribute(&cus, hipDeviceAttributeMultiprocessorCount, dev);
        hipFuncSetAttribute((const void*)mk_fwd, hipFuncAttributeMaxDynamicSharedMemorySize, LDS_BYTES);
        hipOccupancyMaxActiveBlocksPerMultiprocessor(&per_cu, (const void*)mk_fwd, 512, LDS_BYTES);
        if (per_cu < 1) per_cu = 1;
        grid = cus * per_cu;
        if (ws_size < WS_END || n_in != 17) { fprintf(stderr, "kernel_launch: unexpected ws %zu / n_in %d\n", ws_size, n_in); }
    }
    Args a{};
    for (int i = 0; i < 17; ++i) a.in[i] = (const float*)d_in[i];
    a.out = (float*)d_out; a.ws = (unsigned char*)d_ws;
    hipMemsetAsync((char*)d_ws + WS_CTL, 0, CTL_BYTES, stream);
    void* args[] = {&a};
    hipError_t e = hipLaunchCooperativeKernel((const void*)mk_fwd, dim3(grid), dim3(512), args, LDS_BYTES, stream);
    if (e != hipSuccess) fprintf(stderr, "cooperative launch failed: %s (grid %d)\n", hipGetErrorString(e), grid);
}
```
